# Optimizing an MI355X kernel written in HIP

```python
import math, functools
import jax, jax.numpy as jnp
from jax import lax
import numpy as np

D_MODEL = 1024
BATCH = 2
SEQ = 8192
DEPTH = 1
DEC_BATCH = 128
DEC_SEQ = 1
PAST_LEN = 8192
PAGE_SIZE = 128

MLA_HEADS = 8
Q_LORA = 384
KV_LORA = 256
NOPE_DIM = 64
ROPE_DIM = 32
V_DIM = 64
ROPE_THETA = 10000.0
Q_BLOCK = 128
M_HEADS = 4
M_DIM = 128
CHUNK = 128
MLA_WIDTH = MLA_HEADS * V_DIM
MLSTM_WIDTH = M_HEADS * M_DIM
MIX_WIDTH = MLA_WIDTH + MLSTM_WIDTH
D_FF = 2816
PLE_DIM = 256
EPS = 1e-6
OFF_KV = Q_LORA
OFF_KR = OFF_KV + KV_LORA
OFF_MQ = OFF_KR + ROPE_DIM
OFF_MK = OFF_MQ + MLSTM_WIDTH
OFF_MV = OFF_MK + MLSTM_WIDTH
OFF_MO = OFF_MV + MLSTM_WIDTH
OFF_MI = OFF_MO + MLSTM_WIDTH
OFF_MF = OFF_MI + M_HEADS
IN_COLS = OFF_MF + M_HEADS

kernel_name = "hymba_mla_mlstm_macaron_step"


def rmsnorm(x, g):
    xf = x.astype(jnp.float32)
    y = xf * lax.rsqrt(jnp.mean(xf * xf, axis=-1, keepdims=True) + EPS)
    return (y * g.astype(jnp.float32)).astype(x.dtype)


def rope(x, pos):
    half = ROPE_DIM // 2
    inv = ROPE_THETA ** (-jnp.arange(half, dtype=jnp.float32) / half)
    ang = pos.astype(jnp.float32)[:, None] * inv[None, :]
    shape = (1, pos.shape[0]) + (1,) * (x.ndim - 3) + (half,)
    cos = jnp.cos(ang).reshape(shape)
    sin = jnp.sin(ang).reshape(shape)
    xf = x.astype(jnp.float32)
    x1, x2 = xf[..., :half], xf[..., half:]
    return jnp.concatenate([x1 * cos - x2 * sin, x1 * sin + x2 * cos], axis=-1).astype(x.dtype)


def swiglu(x, wg, wu, wd):
    return (jax.nn.silu(x @ wg) * (x @ wu)) @ wd


def prompt_attention(q_nope, q_rope, ckv, krope, w_uk, w_uv):
    B, S, H, _ = q_nope.shape
    qb = math.gcd(S, Q_BLOCK)
    nb = S // qb
    scale = (NOPE_DIM + ROPE_DIM) ** -0.5
    k_nope = (ckv @ w_uk).reshape(B, S, H, NOPE_DIM)
    v = (ckv @ w_uv).reshape(B, S, H, V_DIM)
    qn = q_nope.reshape(B, nb, qb, H, NOPE_DIM).swapaxes(0, 1)
    qr = q_rope.reshape(B, nb, qb, H, ROPE_DIM).swapaxes(0, 1)
    kpos = jnp.arange(S)

    def block(args):
        qn_b, qr_b, bi = args
        s = (jnp.einsum('bqhd,bkhd->bhqk', qn_b, k_nope, preferred_element_type=jnp.float32)
             + jnp.einsum('bqhr,bkr->bhqk', qr_b, krope, preferred_element_type=jnp.float32)) * scale
        qpos = bi * qb + jnp.arange(qb)
        s = jnp.where(kpos[None, :] <= qpos[:, None], s, -jnp.inf)
        p = jax.nn.softmax(s, axis=-1)
        return jnp.einsum('bhqk,bkhd->bqhd', p.astype(v.dtype), v)

    out = lax.map(block, (qn, qr, jnp.arange(nb)))
    return out.swapaxes(0, 1).reshape(B, S, H * V_DIM)


def sample_attention(q_nope, q_rope, ckv, krope, w_uk, w_uv, cache_c, cache_r, page_table):
    Bd, Sq, H, _ = q_nope.shape
    scale = (NOPE_DIM + ROPE_DIM) ** -0.5
    past_c = cache_c[page_table].reshape(Bd, -1, KV_LORA)
    past_r = cache_r[page_table].reshape(Bd, -1, ROPE_DIM)
    n_past = past_c.shape[1]
    q_abs = jnp.einsum('bqhn,chn->bqhc', q_nope, w_uk.reshape(KV_LORA, H, NOPE_DIM))
    s_past = (jnp.einsum('bqhc,bkc->bhqk', q_abs, past_c, preferred_element_type=jnp.float32)
              + jnp.einsum('bqhr,bkr->bhqk', q_rope, past_r, preferred_element_type=jnp.float32))
    s_new = (jnp.einsum('bqhc,bkc->bhqk', q_abs, ckv, preferred_element_type=jnp.float32)
             + jnp.einsum('bqhr,bkr->bhqk', q_rope, krope, preferred_element_type=jnp.float32))
    causal = jnp.tril(jnp.ones((Sq, Sq), dtype=bool))
    s_new = jnp.where(causal, s_new, -jnp.inf)
    p = jax.nn.softmax(jnp.concatenate([s_past, s_new], axis=-1) * scale, axis=-1)
    p = p.astype(ckv.dtype)
    o_lat = (jnp.einsum('bhqk,bkc->bqhc', p[..., :n_past], past_c)
             + jnp.einsum('bhqk,bkc->bqhc', p[..., n_past:], ckv))
    out = jnp.einsum('bqhc,chv->bqhv', o_lat, w_uv.reshape(KV_LORA, H, V_DIM))
    return out.reshape(Bd, Sq, H * V_DIM)


def mlstm_chunkwise(q, k, v, ig, lf, C0, n0, m0):
    B, S, H, D = q.shape
    L = math.gcd(S, CHUNK)
    nc = S // L
    causal = jnp.tril(jnp.ones((L, L), dtype=bool))

    def to_chunks(a):
        return a.reshape((B, nc, L) + a.shape[2:]).swapaxes(0, 1)

    def step(carry, xs):
        C, n, m = carry
        qc, kc, vc, ic, fc = xs
        bT = jnp.cumsum(fc, axis=1).transpose(0, 2, 1)
        iT = ic.transpose(0, 2, 1)
        Dm = bT[..., :, None] - bT[..., None, :] + iT[..., None, :]
        Dm = jnp.where(causal, Dm, -jnp.inf)
        inter = bT + m[..., None]
        m_row = jnp.maximum(inter, jnp.max(Dm, axis=-1))
        w_inter = jnp.exp(inter - m_row)
        Sqk = jnp.einsum('bthd,bshd->bhts', qc, kc) * jnp.exp(Dm - m_row[..., None])
        w_t = w_inter.transpose(0, 2, 1)[..., None]
        num = jnp.einsum('bhts,bshd->bthd', Sqk, vc) + jnp.einsum('bthd,bhde->bthe', qc, C) * w_t
        den = jnp.sum(Sqk, axis=-1) + jnp.einsum('bthd,bhd->bht', qc, n) * w_inter
        den = jnp.maximum(jnp.abs(den), jnp.exp(-m_row))
        h = num / den.transpose(0, 2, 1)[..., None]
        bL = bT[..., -1]
        g = bL[..., None] - bT + iT
        m_new = jnp.maximum(bL + m, jnp.max(g, axis=-1))
        a = jnp.exp(bL + m - m_new)
        ws = jnp.exp(g - m_new[..., None])
        C_new = a[..., None, None] * C + jnp.einsum('bhs,bshd,bshe->bhde', ws, kc, vc)
        n_new = a[..., None] * n + jnp.einsum('bhs,bshd->bhd', ws, kc)
        return (C_new, n_new, m_new), h

    (C, n, m), hs = lax.scan(step, (C0, n0, m0), (to_chunks(q), to_chunks(k), to_chunks(v), to_chunks(ig), to_chunks(lf)))
    return hs.swapaxes(0, 1).reshape(B, S, H, D), C, n, m


def trunk_layer(x, pe, pos, attn_fn, C0, n0, m0, lw):
    B, S, _ = x.shape
    h = x + 0.5 * swiglu(rmsnorm(x, lw['g_ff1']), lw['w_ff1_gate'], lw['w_ff1_up'], lw['w_ff1_down'])
    z = rmsnorm(h, lw['g_mix']) @ lw['w_in']
    zq, zkv, zkr, mq, mk, mv, mo, mi, mf = jnp.split(
        z, [OFF_KV, OFF_KR, OFF_MQ, OFF_MK, OFF_MV, OFF_MO, OFF_MI, OFF_MF], axis=-1)
    ckv = rmsnorm(zkv, lw['g_kv'])
    krope = rope(zkr, pos)
    q = (rmsnorm(zq, lw['g_q']) @ lw['w_uq']).reshape(B, S, MLA_HEADS, NOPE_DIM + ROPE_DIM)
    q_nope = q[..., :NOPE_DIM]
    q_rope = rope(q[..., NOPE_DIM:], pos)
    a = attn_fn(q_nope, q_rope, ckv, krope, lw['w_uk'], lw['w_uv'])
    f32 = jnp.float32
    qm = mq.astype(f32).reshape(B, S, M_HEADS, M_DIM)
    km = mk.astype(f32).reshape(B, S, M_HEADS, M_DIM) * (M_DIM ** -0.5)
    vm = mv.astype(f32).reshape(B, S, M_HEADS, M_DIM)
    ig = mi.astype(f32) + lw['b_gate_i'].astype(f32)
    lf = jax.nn.log_sigmoid(mf.astype(f32) + lw['b_gate_f'].astype(f32))
    hm, C, n, m = mlstm_chunkwise(qm, km, vm, ig, lf, C0, n0, m0)
    hm = jax.nn.sigmoid(mo.astype(f32)).reshape(B, S, M_HEADS, M_DIM) * hm
    hm = rmsnorm(hm, lw['g_mlstm_out']).reshape(B, S, MLSTM_WIDTH).astype(x.dtype)
    mix = jnp.concatenate([rmsnorm(a, lw['g_attn_out']), hm], axis=-1) @ lw['w_out']
    h = h + mix
    h = h + 0.5 * swiglu(rmsnorm(h, lw['g_ff2']), lw['w_ff2_gate'], lw['w_ff2_up'], lw['w_ff2_down'])
    h = h + jax.nn.sigmoid(rmsnorm(h, lw['g_ple']) @ lw['w_ple_gate']) * (pe @ lw['w_ple_proj'])
    return h, ckv, krope, C, n, m


def setup_inputs(seed: int = 0) -> dict:
    key = jax.random.key(seed)
    ks = iter(jax.random.split(key, 64))
    f32 = jnp.float32

    def normal(shape, scale=1.0):
        return jax.random.normal(next(ks), shape, f32) * scale

    def gain(shape):
        return 1.0 + normal(shape, 0.02)

    def dense(fan_in, fan_out):
        return normal((DEPTH, fan_in, fan_out), fan_in ** -0.5)

    n_pages = PAST_LEN // PAGE_SIZE
    n_used = DEC_BATCH * n_pages
    n_phys = (n_used * 5) // 4
    page_table = jax.random.permutation(next(ks), n_phys)[:n_used].reshape(DEC_BATCH, n_pages).astype(jnp.int32)
    b_f = jnp.broadcast_to(jnp.linspace(3.0, 6.0, M_HEADS, dtype=f32), (DEPTH, M_HEADS)) + normal((DEPTH, M_HEADS), 0.01)
    return {
        'x_prompt': normal((BATCH, SEQ, D_MODEL)),
        'x_sample': normal((DEC_BATCH, DEC_SEQ, D_MODEL)),
        'p_prompt': normal((DEPTH, BATCH, SEQ, PLE_DIM)),
        'p_sample': normal((DEPTH, DEC_BATCH, DEC_SEQ, PLE_DIM)),
        'cache_ckv': normal((DEPTH, n_phys, PAGE_SIZE, KV_LORA)),
        'cache_krope': normal((DEPTH, n_phys, PAGE_SIZE, ROPE_DIM)),
        'state_C': normal((DEPTH, DEC_BATCH, M_HEADS, M_DIM, M_DIM), 0.5),
        'state_n': normal((DEPTH, DEC_BATCH, M_HEADS, M_DIM), 0.5),
        'state_m': normal((DEPTH, DEC_BATCH, M_HEADS), 0.5),
        'page_table': page_table,
        'g_ff1': gain((DEPTH, D_MODEL)),
        'w_ff1_gate': dense(D_MODEL, D_FF),
        'w_ff1_up': dense(D_MODEL, D_FF),
        'w_ff1_down': dense(D_FF, D_MODEL),
        'g_mix': gain((DEPTH, D_MODEL)),
        'w_in': dense(D_MODEL, IN_COLS),
        'g_q': gain((DEPTH, Q_LORA)),
        'w_uq': dense(Q_LORA, MLA_HEADS * (NOPE_DIM + ROPE_DIM)),
        'g_kv': gain((DEPTH, KV_LORA)),
        'w_uk': dense(KV_LORA, MLA_HEADS * NOPE_DIM),
        'w_uv': dense(KV_LORA, MLA_HEADS * V_DIM),
        'b_gate_i': normal((DEPTH, M_HEADS), 0.1),
        'b_gate_f': b_f,
        'g_attn_out': gain((DEPTH, MLA_WIDTH)),
        'g_mlstm_out': gain((DEPTH, M_HEADS, M_DIM)),
        'w_out': dense(MIX_WIDTH, D_MODEL),
        'g_ff2': gain((DEPTH, D_MODEL)),
        'w_ff2_gate': dense(D_MODEL, D_FF),
        'w_ff2_up': dense(D_MODEL, D_FF),
        'w_ff2_down': dense(D_FF, D_MODEL),
        'g_ple': gain((DEPTH, D_MODEL)),
        'w_ple_gate': dense(D_MODEL, D_MODEL),
        'w_ple_proj': dense(PLE_DIM, D_MODEL),
        'g_final': gain((D_MODEL,)),
    }


def reference(x_prompt, x_sample, p_prompt, p_sample, cache_ckv, cache_krope, state_C, state_n, state_m,
              page_table, g_ff1, w_ff1_gate, w_ff1_up, w_ff1_down, g_mix, w_in, g_q, w_uq, g_kv, w_uk, w_uv,
              b_gate_i, b_gate_f, g_attn_out, g_mlstm_out, w_out, g_ff2, w_ff2_gate, w_ff2_up, w_ff2_down,
              g_ple, w_ple_gate, w_ple_proj, g_final):
    f32 = jnp.float32
    pos_p = jnp.arange(SEQ)
    pos_s = PAST_LEN + jnp.arange(DEC_SEQ)
    hp, hs = x_prompt, x_sample
    ckv_p, kr_p, C_p, n_p, m_p = [], [], [], [], []
    ckv_s, kr_s, C_s, n_s, m_s = [], [], [], [], []
    for i in range(DEPTH):
        lw = dict(g_ff1=g_ff1[i], w_ff1_gate=w_ff1_gate[i], w_ff1_up=w_ff1_up[i], w_ff1_down=w_ff1_down[i],
                  g_mix=g_mix[i], w_in=w_in[i], g_q=g_q[i], w_uq=w_uq[i], g_kv=g_kv[i], w_uk=w_uk[i], w_uv=w_uv[i],
                  b_gate_i=b_gate_i[i], b_gate_f=b_gate_f[i], g_attn_out=g_attn_out[i], g_mlstm_out=g_mlstm_out[i],
                  w_out=w_out[i], g_ff2=g_ff2[i], w_ff2_gate=w_ff2_gate[i], w_ff2_up=w_ff2_up[i],
                  w_ff2_down=w_ff2_down[i], g_ple=g_ple[i], w_ple_gate=w_ple_gate[i], w_ple_proj=w_ple_proj[i])
        C0 = jnp.zeros((BATCH, M_HEADS, M_DIM, M_DIM), f32)
        n0 = jnp.zeros((BATCH, M_HEADS, M_DIM), f32)
        m0 = jnp.zeros((BATCH, M_HEADS), f32)
        hp, c1, r1, C1, n1, m1 = trunk_layer(hp, p_prompt[i], pos_p, prompt_attention, C0, n0, m0, lw)
        ckv_p.append(c1); kr_p.append(r1); C_p.append(C1); n_p.append(n1); m_p.append(m1)
        attn_s = functools.partial(sample_attention, cache_c=cache_ckv[i], cache_r=cache_krope[i], page_table=page_table)
        hs, c2, r2, C2, n2, m2 = trunk_layer(hs, p_sample[i], pos_s, attn_s, state_C[i].astype(f32),
                                             state_n[i].astype(f32), state_m[i].astype(f32), lw)
        ckv_s.append(c2); kr_s.append(r2); C_s.append(C2); n_s.append(n2); m_s.append(m2)
    y_prompt = rmsnorm(hp, g_final)
    y_sample = rmsnorm(hs, g_final)
    return (y_prompt, y_sample,
            jnp.stack(ckv_p), jnp.stack(kr_p), jnp.stack(C_p), jnp.stack(n_p), jnp.stack(m_p),
            jnp.stack(ckv_s), jnp.stack(kr_s), jnp.stack(C_s), jnp.stack(n_s), jnp.stack(m_s))
```

```cpp
#include <hip/hip_runtime.h>
#include <stdint.h>
#include <math.h>
namespace nv {
constexpr int DM = 1024, NB = 2, S = 8192, MP = NB * S, MS = 128, MT = MP + MS, FF = 2816, NIN = 2728;
constexpr int QL = 384, KVL = 256, RD = 32, NH = 8, ND = 64, VD = 64, QD = ND + RD, MH = 4, MD = 128, PLE = 256;
constexpr int NPAGE = 64, PAGE = 128, PAST = 8192;
constexpr float EPS = 1e-6f;
constexpr int OFF_KV = 384, OFF_KR = 640, OFF_MQ = 672, OFF_MK = 1184, OFF_MV = 1696, OFF_MO = 2208, OFF_MI = 2720, OFF_MF = 2724;

__global__ __launch_bounds__(256) void gemm_f32(const float* __restrict__ A, int lda, const float* __restrict__ W, int ldw,
                                                float* __restrict__ C, int ldc, int M, int N, int K) {
    __shared__ float As[16][65];
    __shared__ float Ws[16][65];
    const int tx = threadIdx.x & 15, ty = threadIdx.x >> 4;
    const int m0 = blockIdx.y * 64, n0 = blockIdx.x * 64;
    float acc[4][4];
#pragma unroll
    for (int i = 0; i < 4; ++i)
#pragma unroll
        for (int j = 0; j < 4; ++j) acc[i][j] = 0.f;
    for (int k0 = 0; k0 < K; k0 += 16) {
        for (int i = threadIdx.x; i < 1024; i += 256) { const int r = i >> 4, c = i & 15; const int gr = m0 + r; As[c][r] = gr < M ? A[(size_t)gr * lda + k0 + c] : 0.f; }
        for (int i = threadIdx.x; i < 1024; i += 256) { const int r = i >> 6, c = i & 63; const int gc = n0 + c; Ws[r][c] = gc < N ? W[(size_t)(k0 + r) * ldw + gc] : 0.f; }
        __syncthreads();
#pragma unroll
        for (int kk = 0; kk < 16; ++kk) {
            float a[4], b[4];
#pragma unroll
            for (int i = 0; i < 4; ++i) { a[i] = As[kk][ty * 4 + i]; b[i] = Ws[kk][tx * 4 + i]; }
#pragma unroll
            for (int i = 0; i < 4; ++i)
#pragma unroll
                for (int j = 0; j < 4; ++j) acc[i][j] = fmaf(a[i], b[j], acc[i][j]);
        }
        __syncthreads();
    }
#pragma unroll
    for (int i = 0; i < 4; ++i)
#pragma unroll
        for (int j = 0; j < 4; ++j) { const int gr = m0 + ty * 4 + i, gc = n0 + tx * 4 + j; if (gr < M && gc < N) C[(size_t)gr * ldc + gc] = acc[i][j]; }
}
static void gemm(hipStream_t st, const float* A, int lda, const float* W, int ldw, float* C, int ldc, int M, int N, int K) {
    gemm_f32<<<dim3((N + 63) / 64, (M + 63) / 64), 256, 0, st>>>(A, lda, W, ldw, C, ldc, M, N, K);
}
__device__ __forceinline__ float wsum(float v) {
#pragma unroll
    for (int o = 32; o > 0; o >>= 1) v += __shfl_xor(v, o);
    return v;
}
__global__ void rms_rows(const float* __restrict__ in, int ldi, const float* __restrict__ g, float* __restrict__ out, int ldo, int ncols, int nrows) {
    const int row = blockIdx.x * 4 + (threadIdx.x >> 6), lane = threadIdx.x & 63;
    if (row >= nrows) return;
    const float* x = in + (size_t)row * ldi;
    float s = 0.f;
    for (int c = lane; c < ncols; c += 64) s += x[c] * x[c];
    s = wsum(s);
    const float r = rsqrtf(s / (float)ncols + EPS);
    for (int c = lane; c < ncols; c += 64) out[(size_t)row * ldo + c] = x[c] * r * g[c];
}
static void rms(hipStream_t st, const float* in, int ldi, const float* g, float* out, int ldo, int ncols, int nrows) {
    rms_rows<<<(nrows + 3) / 4, 256, 0, st>>>(in, ldi, g, out, ldo, ncols, nrows);
}
__global__ void swiglu_k(const float* __restrict__ G, const float* __restrict__ U, float* __restrict__ A, size_t n) {
    for (size_t i = (size_t)blockIdx.x * 256 + threadIdx.x; i < n; i += (size_t)gridDim.x * 256) { const float g = G[i]; A[i] = g / (1.f + expf(-g)) * U[i]; }
}
__global__ void axpy_k(const float* __restrict__ X, const float* __restrict__ Y, float s, float* __restrict__ O, size_t n) {
    for (size_t i = (size_t)blockIdx.x * 256 + threadIdx.x; i < n; i += (size_t)gridDim.x * 256) O[i] = X[i] + s * Y[i];
}
__global__ void ple_k(const float* __restrict__ H, const float* __restrict__ G, const float* __restrict__ P, float* __restrict__ O, size_t n) {
    for (size_t i = (size_t)blockIdx.x * 256 + threadIdx.x; i < n; i += (size_t)gridDim.x * 256) O[i] = H[i] + P[i] / (1.f + expf(-G[i]));
}
__device__ __forceinline__ int pos_of(int row) { return row < MP ? (row & (S - 1)) : PAST; }
__global__ void rope_k(const float* in, int ldi, int goff, int gstride, int ng, float* out, int ldo, int ooff, int ostride, int nrows) {
    const int idx = blockIdx.x * 256 + threadIdx.x;
    const int i = idx & 15, gi = (idx >> 4) % ng, row = (idx >> 4) / ng;
    if (row >= nrows) return;
    const float inv = powf(10000.0f, -(float)i / 16.0f);
    const float ang = (float)pos_of(row) * inv;
    const float c = cosf(ang), s = sinf(ang);
    const float x1 = in[(size_t)row * ldi + goff + gi * gstride + i], x2 = in[(size_t)row * ldi + goff + gi * gstride + 16 + i];
    out[(size_t)row * ldo + ooff + gi * ostride + i] = x1 * c - x2 * s;
    out[(size_t)row * ldo + ooff + gi * ostride + 16 + i] = x1 * s + x2 * c;
}
__global__ __launch_bounds__(256) void attn_prompt_k(const float* __restrict__ q, const float* __restrict__ kn, const float* __restrict__ kr,
                                                     const float* __restrict__ v, float* __restrict__ o) {
    __shared__ float Qs[64][97];
    __shared__ float Ks[32][97];
    __shared__ float Vs[32][65];
    __shared__ float Ps[64][33];
    const int tid = threadIdx.x, qi = tid >> 2, part = tid & 3;
    const int qb = blockIdx.x, h = blockIdx.y, b = blockIdx.z;
    const size_t rb = (size_t)b * S;
    const float scale = 0.10206207261596575f;
    for (int i = tid; i < 64 * 96; i += 256) { const int r = i / 96, c = i % 96; Qs[r][c] = q[(rb + qb * 64 + r) * 768 + h * 96 + c]; }
    float m = -INFINITY, l = 0.f, acc[16];
#pragma unroll
    for (int d = 0; d < 16; ++d) acc[d] = 0.f;
    const int qpos = qb * 64 + qi;
    const int ntile = (qb * 64 + 64) / 32;
    for (int t = 0; t < ntile; ++t) {
        __syncthreads();
        for (int i = tid; i < 32 * 96; i += 256) { const int r = i / 96, c = i % 96; const size_t kr_ = rb + t * 32 + r;
            Ks[r][c] = c < 64 ? kn[kr_ * 512 + h * 64 + c] : kr[kr_ * 32 + (c - 64)]; }
        for (int i = tid; i < 32 * 64; i += 256) { const int r = i >> 6, c = i & 63; Vs[r][c] = v[(rb + t * 32 + r) * 512 + h * 64 + c]; }
        __syncthreads();
        float sc[8]; float tm = -INFINITY;
#pragma unroll
        for (int j = 0; j < 8; ++j) { const int key = part * 8 + j; float s = 0.f;
            for (int d = 0; d < 96; ++d) s = fmaf(Qs[qi][d], Ks[key][d], s);
            s *= scale; if (t * 32 + key > qpos) s = -INFINITY; sc[j] = s; tm = fmaxf(tm, s); }
        tm = fmaxf(tm, __shfl_xor(tm, 1)); tm = fmaxf(tm, __shfl_xor(tm, 2));
        const float mn = fmaxf(m, tm);
        const float alpha = (mn == -INFINITY) ? 1.f : expf(m - mn);
        float ps = 0.f;
#pragma unroll
        for (int j = 0; j < 8; ++j) { const float p = (sc[j] == -INFINITY) ? 0.f : expf(sc[j] - mn); ps += p; Ps[qi][part * 8 + j] = p; }
        ps += __shfl_xor(ps, 1); ps += __shfl_xor(ps, 2);
        l = l * alpha + ps; m = mn;
#pragma unroll
        for (int d = 0; d < 16; ++d) acc[d] *= alpha;
        __syncthreads();
        for (int key = 0; key < 32; ++key) { const float p = Ps[qi][key];
#pragma unroll
            for (int d = 0; d < 16; ++d) acc[d] = fmaf(p, Vs[key][part * 16 + d], acc[d]); }
    }
    const float il = 1.f / l;
#pragma unroll
    for (int d = 0; d < 16; ++d) o[(rb + qpos) * 512 + h * 64 + part * 16 + d] = acc[d] * il;
}
__global__ __launch_bounds__(256) void attn_sample_k(const float* __restrict__ q, const float* __restrict__ ckvn, const float* __restrict__ krn,
                                                     const float* __restrict__ cache_c, const float* __restrict__ cache_r, const int* __restrict__ pt,
                                                     const float* __restrict__ w_uk, const float* __restrict__ w_uv, float* __restrict__ o) {
    __shared__ float sc[PAST + 1];
    __shared__ float qa[KVL];
    __shared__ float qr[RD];
    __shared__ float qn[ND];
    __shared__ float red[256];
    __shared__ float ol[KVL];
    const int tid = threadIdx.x, h = blockIdx.x, bs = blockIdx.y;
    const float scale = 0.10206207261596575f;
    const float* qrow = q + (size_t)(MP + bs) * 768 + h * 96;
    if (tid < 64) qn[tid] = qrow[tid]; else if (tid < 96) qr[tid - 64] = qrow[tid];
    __syncthreads();
    { float s = 0.f; for (int n = 0; n < ND; ++n) s = fmaf(qn[n], w_uk[(size_t)tid * 512 + h * 64 + n], s); qa[tid] = s; }
    __syncthreads();
    float lm = -INFINITY;
    for (int k = tid; k <= PAST; k += 256) {
        const float* c; const float* r;
        if (k < PAST) { const int pg = pt[bs * NPAGE + (k >> 7)]; c = cache_c + ((size_t)pg * PAGE + (k & 127)) * KVL; r = cache_r + ((size_t)pg * PAGE + (k & 127)) * RD; }
        else { c = ckvn + (size_t)(MP + bs) * KVL; r = krn + (size_t)(MP + bs) * RD; }
        float s = 0.f;
        for (int i = 0; i < KVL; ++i) s = fmaf(qa[i], c[i], s);
        for (int i = 0; i < RD; ++i) s = fmaf(qr[i], r[i], s);
        s *= scale; sc[k] = s; lm = fmaxf(lm, s);
    }
    red[tid] = lm; __syncthreads();
    for (int o2 = 128; o2 > 0; o2 >>= 1) { if (tid < o2) red[tid] = fmaxf(red[tid], red[tid + o2]); __syncthreads(); }
    const float mx = red[0]; __syncthreads();
    float ls = 0.f;
    for (int k = tid; k <= PAST; k += 256) { const float p = expf(sc[k] - mx); sc[k] = p; ls += p; }
    red[tid] = ls; __syncthreads();
    for (int o2 = 128; o2 > 0; o2 >>= 1) { if (tid < o2) red[tid] += red[tid + o2]; __syncthreads(); }
    const float inv = 1.f / red[0]; __syncthreads();
    float a = 0.f;
    for (int k = 0; k <= PAST; ++k) {
        const float* c;
        if (k < PAST) { const int pg = pt[bs * NPAGE + (k >> 7)]; c = cache_c + ((size_t)pg * PAGE + (k & 127)) * KVL; } else c = ckvn + (size_t)(MP + bs) * KVL;
        a = fmaf(sc[k], c[tid], a);
    }
    ol[tid] = a * inv; __syncthreads();
    if (tid < VD) { float s = 0.f; for (int c = 0; c < KVL; ++c) s = fmaf(ol[c], w_uv[(size_t)c * 512 + h * 64 + tid], s); o[(size_t)bs * 512 + h * 64 + tid] = s; }
}
__global__ __launch_bounds__(512) void mlstm_k(const float* __restrict__ z, const float* __restrict__ bi, const float* __restrict__ bf, const float* __restrict__ gout,
                                               const float* __restrict__ sC, const float* __restrict__ sn, const float* __restrict__ sm,
                                               float* __restrict__ hm, float* __restrict__ Cp, float* __restrict__ np_, float* __restrict__ mp,
                                               float* __restrict__ Cs, float* __restrict__ ns, float* __restrict__ ms) {
    __shared__ float qs[MD], ks[MD], vs[MD], nn[MD], red[4][MD], hh[MD];
    const int tid = threadIdx.x, dv = tid & 127, part = tid >> 7, h = blockIdx.x, sq = blockIdx.y;
    const bool prompt = sq < NB;
    const int T = prompt ? S : 1;
    const size_t row0 = prompt ? (size_t)sq * S : (size_t)MP + (sq - NB);
    float C[32]; float m;
    if (prompt) {
#pragma unroll
        for (int i = 0; i < 32; ++i) C[i] = 0.f;
        if (tid < MD) nn[tid] = 0.f; m = 0.f;
    } else {
        const int bs = sq - NB;
#pragma unroll
        for (int i = 0; i < 32; ++i) C[i] = sC[(((size_t)bs * MH + h) * MD + part * 32 + i) * MD + dv];
        if (tid < MD) nn[tid] = sn[((size_t)bs * MH + h) * MD + tid]; m = sm[bs * MH + h];
    }
    __syncthreads();
    for (int t = 0; t < T; ++t) {
        const float* zr = z + (row0 + t) * NIN;
        if (tid < 128) qs[tid] = zr[OFF_MQ + h * MD + tid];
        else if (tid < 256) ks[tid - 128] = zr[OFF_MK + h * MD + tid - 128] * 0.08838834764831845f;
        else if (tid < 384) vs[tid - 256] = zr[OFF_MV + h * MD + tid - 256];
        const float ig = zr[OFF_MI + h] + bi[h];
        const float fp = zr[OFF_MF + h] + bf[h];
        const float lf = fminf(fp, 0.f) - log1pf(expf(-fabsf(fp)));
        const float mnew = fmaxf(lf + m, ig);
        const float a = expf(lf + m - mnew), w = expf(ig - mnew);
        __syncthreads();
        float pn = 0.f;
        const float wv = w * vs[dv];
#pragma unroll
        for (int i = 0; i < 32; ++i) { const int dk = part * 32 + i; C[i] = fmaf(a, C[i], wv * ks[dk]); pn = fmaf(qs[dk], C[i], pn); }
        red[part][dv] = pn;
        if (tid < MD) nn[tid] = fmaf(a, nn[tid], w * ks[tid]);
        __syncthreads();
        if (part == 0) {
            float qn = 0.f;
            for (int d = 0; d < MD; ++d) qn = fmaf(qs[d], nn[d], qn);
            const float den = fmaxf(fabsf(qn), expf(-mnew));
            const float num = red[0][dv] + red[1][dv] + red[2][dv] + red[3][dv];
            const float og = zr[OFF_MO + h * MD + dv];
            hh[dv] = num / den / (1.f + expf(-og));
        }
        __syncthreads();
        if (part == 0) {
            float ss = 0.f;
            for (int d = 0; d < MD; ++d) ss = fmaf(hh[d], hh[d], ss);
            hm[(row0 + t) * 512 + h * MD + dv] = hh[dv] * rsqrtf(ss / (float)MD + EPS) * gout[h * MD + dv];
        }
        m = mnew;
        __syncthreads();
    }
    float* Co = prompt ? Cp + ((size_t)sq * MH + h) * MD * MD : Cs + ((size_t)(sq - NB) * MH + h) * MD * MD;
    float* no = prompt ? np_ + ((size_t)sq * MH + h) * MD : ns + ((size_t)(sq - NB) * MH + h) * MD;
    float* mo = prompt ? mp + sq * MH + h : ms + (sq - NB) * MH + h;
#pragma unroll
    for (int i = 0; i < 32; ++i) Co[(size_t)(part * 32 + i) * MD + dv] = C[i];
    if (tid < MD) no[tid] = nn[tid];
    if (tid == 0) *mo = m;
}
__global__ void copy2d_k(const float* __restrict__ in, int ldi, float* __restrict__ out, int ldo, int ncols, int nrows) {
    for (size_t i = (size_t)blockIdx.x * 256 + threadIdx.x; i < (size_t)ncols * nrows; i += (size_t)gridDim.x * 256) { const size_t r = i / ncols, c = i % ncols; out[r * ldo + c] = in[r * ldi + c]; }
}

struct Out { float *y_p, *y_s, *ckv_p, *kr_p, *C_p, *n_p, *m_p, *ckv_s, *kr_s, *C_s, *n_s, *m_s; };
static Out carve_out(float* o) {
    Out r; size_t off = 0;
    r.y_p = o + off; off += (size_t)MP * DM; r.y_s = o + off; off += (size_t)MS * DM;
    r.ckv_p = o + off; off += (size_t)MP * KVL; r.kr_p = o + off; off += (size_t)MP * RD;
    r.C_p = o + off; off += (size_t)NB * MH * MD * MD; r.n_p = o + off; off += (size_t)NB * MH * MD; r.m_p = o + off; off += NB * MH;
    r.ckv_s = o + off; off += (size_t)MS * KVL; r.kr_s = o + off; off += (size_t)MS * RD;
    r.C_s = o + off; off += (size_t)MS * MH * MD * MD; r.n_s = o + off; off += (size_t)MS * MH * MD; r.m_s = o + off; off += MS * MH;
    return r;
}
struct Ws { float *x, *xn, *G, *U, *h1, *z, *ckv, *kr, *qn, *q, *kn, *v, *att, *mix, *t1, *h2, *h3, *pg, *pp, *pe, *h4; };
static size_t carve_ws(float* ws, Ws& w) {
    size_t off = 0; auto take = [&](size_t n) { float* p = ws + off; off += (n + 63) / 64 * 64; return p; };
    w.x = take((size_t)MT * DM); w.xn = take((size_t)MT * DM); w.G = take((size_t)MT * FF); w.U = take((size_t)MT * FF);
    w.h1 = take((size_t)MT * DM); w.z = take((size_t)MT * NIN); w.ckv = take((size_t)MT * KVL); w.kr = take((size_t)MT * RD);
    w.qn = take((size_t)MT * QL); w.q = take((size_t)MT * 768); w.kn = take((size_t)MP * 512); w.v = take((size_t)MP * 512);
    w.att = take((size_t)MT * 512); w.mix = take((size_t)MT * DM); w.t1 = take((size_t)MT * DM); w.h2 = take((size_t)MT * DM); w.h3 = take((size_t)MT * DM);
    w.pg = take((size_t)MT * DM); w.pp = take((size_t)MT * DM); w.pe = take((size_t)MT * PLE); w.h4 = take((size_t)MT * DM);
    return off;
}
static void run(void* const* d_in, float* d_out, float* wsf, hipStream_t st) {
    const float* x_p = (const float*)d_in[0]; const float* x_s = (const float*)d_in[1]; const float* p_p = (const float*)d_in[2]; const float* p_s = (const float*)d_in[3];
    const float* cache_c = (const float*)d_in[4]; const float* cache_r = (const float*)d_in[5]; const float* sC = (const float*)d_in[6]; const float* sn = (const float*)d_in[7];
    const float* sm = (const float*)d_in[8]; const int* pt = (const int*)d_in[9];
    const float* g_ff1 = (const float*)d_in[10]; const float* w1g = (const float*)d_in[11]; const float* w1u = (const float*)d_in[12]; const float* w1d = (const float*)d_in[13];
    const float* g_mix = (const float*)d_in[14]; const float* w_in = (const float*)d_in[15]; const float* g_q = (const float*)d_in[16]; const float* w_uq = (const float*)d_in[17];
    const float* g_kv = (const float*)d_in[18]; const float* w_uk = (const float*)d_in[19]; const float* w_uv = (const float*)d_in[20];
    const float* b_i = (const float*)d_in[21]; const float* b_f = (const float*)d_in[22]; const float* g_ao = (const float*)d_in[23]; const float* g_mo = (const float*)d_in[24];
    const float* w_out = (const float*)d_in[25]; const float* g_ff2 = (const float*)d_in[26]; const float* w2g = (const float*)d_in[27]; const float* w2u = (const float*)d_in[28];
    const float* w2d = (const float*)d_in[29]; const float* g_ple = (const float*)d_in[30]; const float* w_pg = (const float*)d_in[31]; const float* w_pp = (const float*)d_in[32];
    const float* g_fin = (const float*)d_in[33];
    Out O = carve_out(d_out); Ws w; carve_ws(wsf, w);
    const int EG = 2048;
    hipMemcpyAsync(w.x, x_p, (size_t)MP * DM * 4, hipMemcpyDeviceToDevice, st);
    hipMemcpyAsync(w.x + (size_t)MP * DM, x_s, (size_t)MS * DM * 4, hipMemcpyDeviceToDevice, st);
    hipMemcpyAsync(w.pe, p_p, (size_t)MP * PLE * 4, hipMemcpyDeviceToDevice, st);
    hipMemcpyAsync(w.pe + (size_t)MP * PLE, p_s, (size_t)MS * PLE * 4, hipMemcpyDeviceToDevice, st);
    rms(st, w.x, DM, g_ff1, w.xn, DM, DM, MT);
    gemm(st, w.xn, DM, w1g, FF, w.G, FF, MT, FF, DM); gemm(st, w.xn, DM, w1u, FF, w.U, FF, MT, FF, DM);
    swiglu_k<<<EG, 256, 0, st>>>(w.G, w.U, w.G, (size_t)MT * FF);
    gemm(st, w.G, FF, w1d, DM, w.t1, DM, MT, DM, FF);
    axpy_k<<<EG, 256, 0, st>>>(w.x, w.t1, 0.5f, w.h1, (size_t)MT * DM);
    rms(st, w.h1, DM, g_mix, w.xn, DM, DM, MT);
    gemm(st, w.xn, DM, w_in, NIN, w.z, NIN, MT, NIN, DM);
    rms(st, w.z + OFF_KV, NIN, g_kv, w.ckv, KVL, KVL, MT);
    rope_k<<<(MT * 16 + 255) / 256, 256, 0, st>>>(w.z, NIN, OFF_KR, 0, 1, w.kr, RD, 0, 0, MT);
    rms(st, w.z, NIN, g_q, w.qn, QL, QL, MT);
    gemm(st, w.qn, QL, w_uq, 768, w.q, 768, MT, 768, QL);
    rope_k<<<(MT * 16 * NH + 255) / 256, 256, 0, st>>>(w.q, 768, 64, 96, NH, w.q, 768, 64, 96, MT);
    gemm(st, w.ckv, KVL, w_uk, 512, w.kn, 512, MP, 512, KVL); gemm(st, w.ckv, KVL, w_uv, 512, w.v, 512, MP, 512, KVL);
    attn_prompt_k<<<dim3(S / 64, NH, NB), 256, 0, st>>>(w.q, w.kn, w.kr, w.v, w.att);
    attn_sample_k<<<dim3(NH, MS), 256, 0, st>>>(w.q, w.ckv, w.kr, cache_c, cache_r, pt, w_uk, w_uv, w.att + (size_t)MP * 512);
    hipMemcpyAsync(O.ckv_p, w.ckv, (size_t)MP * KVL * 4, hipMemcpyDeviceToDevice, st); hipMemcpyAsync(O.ckv_s, w.ckv + (size_t)MP * KVL, (size_t)MS * KVL * 4, hipMemcpyDeviceToDevice, st);
    hipMemcpyAsync(O.kr_p, w.kr, (size_t)MP * RD * 4, hipMemcpyDeviceToDevice, st); hipMemcpyAsync(O.kr_s, w.kr + (size_t)MP * RD, (size_t)MS * RD * 4, hipMemcpyDeviceToDevice, st);
    rms(st, w.att, 512, g_ao, w.mix, DM, 512, MT);
    mlstm_k<<<dim3(MH, NB + MS), 512, 0, st>>>(w.z, b_i, b_f, g_mo, sC, sn, sm, w.G, O.C_p, O.n_p, O.m_p, O.C_s, O.n_s, O.m_s);
    copy2d_k<<<EG, 256, 0, st>>>(w.G, 512, w.mix + 512, DM, 512, MT);
    gemm(st, w.mix, DM, w_out, DM, w.t1, DM, MT, DM, DM);
    axpy_k<<<EG, 256, 0, st>>>(w.h1, w.t1, 1.0f, w.h2, (size_t)MT * DM);
    rms(st, w.h2, DM, g_ff2, w.xn, DM, DM, MT);
    gemm(st, w.xn, DM, w2g, FF, w.G, FF, MT, FF, DM); gemm(st, w.xn, DM, w2u, FF, w.U, FF, MT, FF, DM);
    swiglu_k<<<EG, 256, 0, st>>>(w.G, w.U, w.G, (size_t)MT * FF);
    gemm(st, w.G, FF, w2d, DM, w.t1, DM, MT, DM, FF);
    axpy_k<<<EG, 256, 0, st>>>(w.h2, w.t1, 0.5f, w.h3, (size_t)MT * DM);
    rms(st, w.h3, DM, g_ple, w.xn, DM, DM, MT);
    gemm(st, w.xn, DM, w_pg, DM, w.pg, DM, MT, DM, DM);
    gemm(st, w.pe, PLE, w_pp, DM, w.pp, DM, MT, DM, PLE);
    ple_k<<<EG, 256, 0, st>>>(w.h3, w.pg, w.pp, w.h4, (size_t)MT * DM);
    rms(st, w.h4, DM, g_fin, O.y_p, DM, DM, MP);
    rms(st, w.h4 + (size_t)MP * DM, DM, g_fin, O.y_s, DM, DM, MS);
}
}

extern "C" void kernel_launch(void* const* d_in, const int* in_sizes, int n_in,
                              void* d_out, int out_size, void* d_ws, size_t ws_size,
                              hipStream_t stream) {
    nv::run(d_in, (float*)d_out, (float*)d_ws, stream);
}
```

```cpp
#define DBG 0
#define DBG_REPORT -1
#include <hip/hip_runtime.h>
#include <cstdio>
#include <cstdint>
#include <math.h>
#define LAS __attribute__((address_space(3)))
#define GAS __attribute__((address_space(1)))
namespace fx {
constexpr int DM = 1024, NB = 2, S = 8192, MP = NB * S, MS = 128, MT = MP + MS, MPAD = 16640, FF = 2816;
constexpr int QL = 384, KVL = 256, RD = 32, NH = 8, MH = 4, MD = 128, PLE = 256;
constexpr int NPAGE = 64, PAGE = 128, PAST = 8192;
constexpr float EPS = 1e-6f;
constexpr float LOG2E = 1.4426950408889634f;
constexpr float ATT_SCALE = 0.10206207261596575f;
typedef unsigned short bf16_t;
typedef short bf16x8 __attribute__((ext_vector_type(8)));
typedef short s16x4 __attribute__((ext_vector_type(4)));
typedef float f32x4 __attribute__((ext_vector_type(4)));
typedef float f32x16 __attribute__((ext_vector_type(16)));
typedef unsigned u32x4 __attribute__((ext_vector_type(4)));
typedef unsigned u32x2 __attribute__((ext_vector_type(2)));
__constant__ float ROPE_INV[16] = {1.f, 0.562341332f, 0.316227764f, 0.177827939f, 0.100000001f, 0.0562341325f, 0.0316227749f, 0.0177827943f,
                                   0.00999999978f, 0.00562341325f, 0.00316227763f, 0.00177827943f, 0.00100000005f, 0.000562341302f, 0.000316227757f, 0.00017782794f};
__device__ __forceinline__ unsigned cvt_pk_bf16(float lo, float hi) { unsigned r; asm volatile("v_cvt_pk_bf16_f32 %0, %1, %2" : "=v"(r) : "v"(lo), "v"(hi)); return r; }
__device__ __forceinline__ float bf2f(unsigned short b) { return __uint_as_float((unsigned)b << 16); }
__device__ __forceinline__ float bflo(unsigned w) { return __uint_as_float(w << 16); }
__device__ __forceinline__ float bfhi(unsigned w) { return __uint_as_float(w & 0xffff0000u); }
__device__ __forceinline__ float ld_f32_agent(const float* p) { return __uint_as_float(__hip_atomic_load((const unsigned*)p, __ATOMIC_RELAXED, __HIP_MEMORY_SCOPE_AGENT)); }
__device__ __forceinline__ float rstd_of(const float* rsq, int row, float invn) { return rsqrtf(ld_f32_agent(rsq + row) * invn + EPS); }
__device__ __forceinline__ float fast_sigmoid(float x) { return __builtin_amdgcn_rcpf(1.f + __builtin_amdgcn_exp2f(-x * LOG2E)); }
__device__ __forceinline__ int pos_of(int row) { return row < MP ? (row & (S - 1)) : PAST; }
__device__ __forceinline__ void rope_cs(int pos, int i, float& c, float& s) {
    const float ang = (float)pos * ROPE_INV[i];
    const float n = rintf(ang * 0.15915494309189535f);
    float r = fmaf(-n, 6.28125f, ang); r = fmaf(-n, 0.0019353071795864769f, r);
    c = __cosf(r); s = __sinf(r);
}
constexpr int ROPE_NPOS = PAST + 1;
__device__ __forceinline__ float wave_sum(float v) {
#pragma unroll
    for (int o = 1; o < 64; o <<= 1) v += __shfl_xor(v, o);
    return v;
}
__device__ __forceinline__ float log_sigmoid(float x) { return fminf(x, 0.f) - log1pf(__expf(-fabsf(x))); }
}
namespace pg8 {
using namespace fx;
#define PG8_LAS __attribute__((address_space(3)))
constexpr int BM = 256, BK = 64, HALF = 128, HTB = HALF * BK * 2  , STAGE_BYTES = 8 * HTB, NXCD = 8, WGM = 8;

__host__ __device__ __forceinline__ int lds_byte(int r, int c) { const int st = (r >> 4) * 2 + (c >> 5), rr = r & 15, cc = c & 31, ob = rr * 64 + cc * 2; return st * 1024 + (ob ^ (((ob >> 9) & 1) << 5)); }
__host__ __device__ __forceinline__ void stage_rc(int b, int& R, int& C) { const int st = b / 1024, sb = b % 1024, swz = sb ^ (((sb >> 9) & 1) << 5); R = (st >> 1) * 16 + swz / 64; C = (st & 1) * 32 + (swz % 64) / 2; }
__host__ __device__ __forceinline__ int perm32(int rho) { const int n = rho >> 4, i = rho & 15; return 8 * (i >> 2) + 4 * n + (i & 3); }

struct Unit { int pm, pn; };
struct Gemm { const bf16_t* A; const bf16_t* Bt; int M, N, K, lda, ldb; };

struct StaticOrder {
    int nM, nN, nwg, G, c;
    __host__ __device__ void init(int M, int N, int G_, int c_) { nM = M / BM; nN = N / BM; nwg = nM * nN; G = G_; c = c_; }
    __host__ __device__ bool next(int i, Unit& u) const {
        const long L = (long)i * G + c; if (L >= nwg) return false;
        int wgid = (int)L; { const int q = nwg / NXCD, r = nwg % NXCD, xcd = wgid % NXCD, off = wgid / NXCD; wgid = (xcd < r ? xcd * (q + 1) : r * (q + 1) + (xcd - r) * q) + off; }
        const int nig = WGM * nN, gid = wgid / nig, fm = gid * WGM, gsz = (nM - fm) < WGM ? (nM - fm) : WGM;
        u.pm = fm + ((wgid % nig) % gsz); u.pn = (wgid % nig) / gsz; return true;
    }
    __device__ __forceinline__ void a_ready(const Unit&) const {}
    __device__ __forceinline__ void done(const Unit&) const {}
};

typedef f32x4 Acc[2][2][4][2];
__device__ __forceinline__ u32x4 pack8(f32x4 a, f32x4 b) { u32x4 w; w.x = cvt_pk_bf16(a[0], a[1]); w.y = cvt_pk_bf16(a[2], a[3]); w.z = cvt_pk_bf16(b[0], b[1]); w.w = cvt_pk_bf16(b[2], b[3]); return w; }
__device__ __forceinline__ float sumsq8(f32x4 a, f32x4 b) { return (a[0] * a[0] + a[1] * a[1]) + (a[2] * a[2] + a[3] * a[3]) + (b[0] * b[0] + b[1] * b[1]) + (b[2] * b[2] + b[3] * b[3]); }
__device__ __forceinline__ void rowsq_atomic(float (&s)[2][4], float* rsq, int rowbase  , int fq) {
#pragma unroll
    for (int ai = 0; ai < 2; ++ai)
#pragma unroll
        for (int m = 0; m < 4; ++m) { s[ai][m] += __shfl_xor(s[ai][m], 16); s[ai][m] += __shfl_xor(s[ai][m], 32); }
    const float v0 = fq == 0 ? s[0][0] : fq == 1 ? s[0][2] : fq == 2 ? s[1][0] : s[1][2];
    const float v1 = fq == 0 ? s[0][1] : fq == 1 ? s[0][3] : fq == 2 ? s[1][1] : s[1][3];
    const int r0 = rowbase + (fq >> 1) * HALF + (fq & 1) * 32;
    unsafeAtomicAdd(rsq + r0, v0); unsafeAtomicAdd(rsq + r0 + 16, v1);
}
struct EpiBase { static constexpr bool PERM = true, AFTER_DRAIN = false, MIDSCALE = false; };

struct EpiSwiGLU : EpiBase {
    bf16_t* act; const float* rsq;
    __device__ __forceinline__ void operator()(const Acc& acc, const Unit& u, int wr, int wc, int fr, int fq) const {
        const int row0 = u.pm * BM + wr * 64 + fr, col0 = u.pn * HALF + wc * 32 + 8 * fq;
#pragma unroll
        for (int ai = 0; ai < 2; ++ai)
#pragma unroll
            for (int m = 0; m < 4; ++m) { const int row = row0 + ai * HALF + m * 16; const float rs = rstd_of(rsq, row, 1.f / DM);
                f32x4 o[2];
#pragma unroll
                for (int n = 0; n < 2; ++n) { const f32x4 g = acc[ai][0][m][n] * rs, up = acc[ai][1][m][n] * rs;
#pragma unroll
                    for (int i = 0; i < 4; ++i) o[n][i] = g[i] * fast_sigmoid(g[i]) * up[i]; }
                *(u32x4*)(act + (size_t)row * FF + col0) = pack8(o[0], o[1]); }
    }
};
template <int MODE> struct EpiResid : EpiBase {
    static constexpr bool MIDSCALE = (MODE == 1);
    const float* xp; const float* xs; float* H; bf16_t* AB; float* rsq; const float* rsqa;
    __device__ __forceinline__ void mid(Acc& acc, const Unit& u, int wr, int fr) const {
#pragma unroll
        for (int ai = 0; ai < 2; ++ai)
#pragma unroll
            for (int m = 0; m < 4; ++m) { const float rs = rstd_of(rsqa, u.pm * BM + ai * HALF + wr * 64 + m * 16 + fr, 1.f / 512.f);
#pragma unroll
                for (int bj = 0; bj < 2; ++bj)
#pragma unroll
                    for (int n = 0; n < 2; ++n) acc[ai][bj][m][n] *= rs; }
    }
    __device__ __forceinline__ void operator()(const Acc& acc, const Unit& u, int wr, int wc, int fr, int fq) const {
        const int row0 = u.pm * BM + wr * 64 + fr, col0 = u.pn * BM + wc * 32 + 8 * fq;
        float ss[2][4];
#pragma unroll
        for (int ai = 0; ai < 2; ++ai)
#pragma unroll
            for (int m = 0; m < 4; ++m) { const int row = row0 + ai * HALF + m * 16; float s = 0.f;
#pragma unroll
                for (int bj = 0; bj < 2; ++bj) { const int col = col0 + bj * HALF; float* hp = H + (size_t)row * DM + col;
                    f32x4 b0, b1;
                    if (MODE == 0) { const float* xr = row < MP ? xp + (size_t)row * DM + col : xs + (size_t)(row - MP) * DM + col;
                        if (row < MT) { b0 = *(const f32x4*)xr; b1 = *(const f32x4*)(xr + 4); } else { b0 = (f32x4){0.f, 0.f, 0.f, 0.f}; b1 = b0; } }
                    else { b0 = *(const f32x4*)hp; b1 = *(const f32x4*)(hp + 4); }
                    const float sc = (MODE == 1) ? 1.f : 0.5f;
                    const f32x4 o0 = b0 + acc[ai][bj][m][0] * sc, o1 = b1 + acc[ai][bj][m][1] * sc;
                    *(f32x4*)hp = o0; *(f32x4*)(hp + 4) = o1;
                    *(u32x4*)(AB + (size_t)row * DM + col) = pack8(o0, o1);
                    s += sumsq8(o0, o1); }
                ss[ai][m] = s; }
        rowsq_atomic(ss, rsq, row0, fq);
    }
};
struct EpiZ : EpiBase {
    const float* rsq1; const float* ROPE; bf16_t *ZKV, *ZQ, *KB, *MQ; size_t mstride; float* GATES; float *ckv_p, *ckv_s, *kr_p, *kr_s; float *rsqkv, *rsqq;
    __device__ __forceinline__ void operator()(const Acc& acc, const Unit& u, int wr, int wc, int fr, int fq) const {
        const int row0 = u.pm * BM + wr * 64 + fr, pn = u.pn, cw = wc * 32 + 8 * fq;
        float ss[2][4];
#pragma unroll
        for (int ai = 0; ai < 2; ++ai)
#pragma unroll
            for (int m = 0; m < 4; ++m) { const int row = row0 + ai * HALF + m * 16; const float rs = rstd_of(rsq1, row, 1.f / DM); float s = 0.f;
                const f32x4 a0 = acc[ai][0][m][0] * rs, a1 = acc[ai][0][m][1] * rs, c0 = acc[ai][1][m][0] * rs, c1 = acc[ai][1][m][1] * rs;
                if (pn == 0) {
                    *(u32x4*)(ZKV + (size_t)row * KVL + cw) = pack8(a0, a1); *(u32x4*)(ZKV + (size_t)row * KVL + HALF + cw) = pack8(c0, c1);
                    if (row < MT) { float* cp = row < MP ? ckv_p + (size_t)row * KVL + cw : ckv_s + (size_t)(row - MP) * KVL + cw;
                        *(f32x4*)cp = a0; *(f32x4*)(cp + 4) = a1; *(f32x4*)(cp + HALF) = c0; *(f32x4*)(cp + HALF + 4) = c1; }
                    s = sumsq8(a0, a1) + sumsq8(c0, c1);
                } else if (pn == 1) {
                    *(u32x4*)(ZQ + (size_t)row * QL + cw) = pack8(a0, a1); *(u32x4*)(ZQ + (size_t)row * QL + HALF + cw) = pack8(c0, c1);
                    s = sumsq8(a0, a1) + sumsq8(c0, c1);
                } else if (pn == 2) {
                    *(u32x4*)(ZQ + (size_t)row * QL + 256 + cw) = pack8(a0, a1);
                    s = sumsq8(a0, a1);
                    if (wc == 0) {
                        const float* tb = ROPE + (size_t)pos_of(row) * 32 + 4 * fq; const f32x4 cs = *(const f32x4*)tb, sn = *(const f32x4*)(tb + 16);
                        const f32x4 x1 = {c0[0], c0[2], c1[0], c1[2]}, x2 = {c0[1], c0[3], c1[1], c1[3]};
                        const f32x4 o1 = x1 * cs - x2 * sn, o2 = x1 * sn + x2 * cs;
                        if (row < MT) { float* kp = row < MP ? kr_p + (size_t)row * RD : kr_s + (size_t)(row - MP) * RD; *(f32x4*)(kp + 4 * fq) = o1; *(f32x4*)(kp + 16 + 4 * fq) = o2; }
                        if (row < MP) { u32x2 w1, w2; w1.x = cvt_pk_bf16(o1[0], o1[1]); w1.y = cvt_pk_bf16(o1[2], o1[3]); w2.x = cvt_pk_bf16(o2[0], o2[1]); w2.y = cvt_pk_bf16(o2[2], o2[3]);
#pragma unroll
                            for (int h = 0; h < NH; ++h) { bf16_t* kb = KB + (size_t)row * 768 + h * 96 + 64 + 4 * fq; *(u32x2*)kb = w1; *(u32x2*)(kb + 16) = w2; } }
                    } else if (wc == 1 && fq == 0) { *(f32x4*)(GATES + (size_t)row * 8) = c0; *(f32x4*)(GATES + (size_t)row * 8 + 4) = c1; }
                } else {
                    const int t = pn - 3; bf16_t* dst = MQ + (size_t)(t >> 1) * mstride;
                    bf16_t* dp = dst + (size_t)row * 512 + (t & 1) * 256 + cw;
                    *(u32x4*)dp = pack8(a0, a1); *(u32x4*)(dp + HALF) = pack8(c0, c1);
                }
                ss[ai][m] = s; asm volatile("" ::: "memory"); }
        if (pn == 0) rowsq_atomic(ss, rsqkv, row0, fq);
        else if (pn <= 2) rowsq_atomic(ss, rsqq, row0, fq);
    }
};
struct EpiQ : EpiBase {
    const float* rsqq; const float* ROPE; bf16_t* QB;
    __device__ __forceinline__ void operator()(const Acc& acc, const Unit& u, int wr, int wc, int fr, int fq) const {
        const int row0 = u.pm * BM + wr * 64 + fr;
#pragma unroll
        for (int ai = 0; ai < 2; ++ai)
#pragma unroll
            for (int m = 0; m < 4; ++m) { const int row = row0 + ai * HALF + m * 16; const float rs = rstd_of(rsqq, row, 1.f / QL); const int pos = pos_of(row);
#pragma unroll
                for (int bj = 0; bj < 2; ++bj) { const int c = u.pn * BM + bj * HALF + wc * 32 + 8 * fq, h = c / 96, d = c - h * 96;
                    const f32x4 v0 = acc[ai][bj][m][0] * rs, v1 = acc[ai][bj][m][1] * rs;
                    if (d < 64) *(u32x4*)(QB + (size_t)row * 768 + c) = pack8(v0, v1);
                    else { const int i0 = (d - 64) >> 1; const float* tb = ROPE + (size_t)pos * 32 + i0; const f32x4 cs = *(const f32x4*)tb, sn = *(const f32x4*)(tb + 16);
                        const f32x4 x1 = {v0[0], v0[2], v1[0], v1[2]}, x2 = {v0[1], v0[3], v1[1], v1[3]};
                        const f32x4 o1 = x1 * cs - x2 * sn, o2 = x1 * sn + x2 * cs;
                        u32x2 w1, w2; w1.x = cvt_pk_bf16(o1[0], o1[1]); w1.y = cvt_pk_bf16(o1[2], o1[3]); w2.x = cvt_pk_bf16(o2[0], o2[1]); w2.y = cvt_pk_bf16(o2[2], o2[3]);
                        bf16_t* qp = QB + (size_t)row * 768 + h * 96 + 64 + i0; *(u32x2*)qp = w1; *(u32x2*)(qp + 16) = w2; } }
                asm volatile("" ::: "memory"); }
    }
};
struct EpiKV : EpiBase {
    const float* rsqkv; bf16_t *KB, *VB; float *ckv_p, *ckv_s; const float* g_kv;
    __device__ __forceinline__ void operator()(const Acc& acc, const Unit& u, int wr, int wc, int fr, int fq) const {
        const int row0 = u.pm * BM + wr * 64 + fr;
#pragma unroll
        for (int ai = 0; ai < 2; ++ai)
#pragma unroll
            for (int m = 0; m < 4; ++m) { const int row = row0 + ai * HALF + m * 16; const float rs = rstd_of(rsqkv, row, 1.f / KVL);
#pragma unroll
                for (int bj = 0; bj < 2; ++bj) { const int c = u.pn * BM + bj * HALF + wc * 32 + 8 * fq;
                    const u32x4 w = pack8(acc[ai][bj][m][0] * rs, acc[ai][bj][m][1] * rs);
                    if (c < 512) *(u32x4*)(KB + (size_t)row * 768 + (c >> 6) * 96 + (c & 63)) = w; else *(u32x4*)(VB + (size_t)row * 512 + (c - 512)) = w; } }
        const int lane = fr + 16 * fq, wid = wr * 4 + wc, rl = (wid * 64 + lane) >> 1, row = u.pm * BM + rl, cb = u.pn * 64 + (lane & 1) * 32;
        if (row < MT) { float* cp = row < MP ? ckv_p + (size_t)row * KVL + cb : ckv_s + (size_t)(row - MP) * KVL + cb; const float rs = rstd_of(rsqkv, row, 1.f / KVL);
#pragma unroll
            for (int j = 0; j < 8; ++j) { const f32x4 g = *(const f32x4*)(g_kv + cb + 4 * j); f32x4 v = *(f32x4*)(cp + 4 * j); v = v * g * rs; *(f32x4*)(cp + 4 * j) = v; } }
    }
};
struct EpiPlain : EpiBase {
    bf16_t* O; int ldo;
    __device__ __forceinline__ void operator()(const Acc& acc, const Unit& u, int wr, int wc, int fr, int fq) const {
        const int row0 = u.pm * BM + wr * 64 + fr, col0 = u.pn * BM + wc * 32 + 8 * fq;
#pragma unroll
        for (int ai = 0; ai < 2; ++ai)
#pragma unroll
            for (int m = 0; m < 4; ++m)
#pragma unroll
                for (int bj = 0; bj < 2; ++bj) *(u32x4*)(O + (size_t)(row0 + ai * HALF + m * 16) * ldo + col0 + bj * HALF) = pack8(acc[ai][bj][m][0], acc[ai][bj][m][1]);
    }
};
struct EpiPle : EpiBase {
    const float* rsq3; const bf16_t* PROJ; const float* H; float *y_p, *y_s; float* rsq4;
    __device__ __forceinline__ void operator()(const Acc& acc, const Unit& u, int wr, int wc, int fr, int fq) const {
        const int row0 = u.pm * BM + wr * 64 + fr, col0 = u.pn * BM + wc * 32 + 8 * fq;
        float ss[2][4];
#pragma unroll
        for (int ai = 0; ai < 2; ++ai)
#pragma unroll
            for (int m = 0; m < 4; ++m) { const int row = row0 + ai * HALF + m * 16; const float rs = rstd_of(rsq3, row, 1.f / DM); float s = 0.f;
#pragma unroll
                for (int bj = 0; bj < 2; ++bj) { const int col = col0 + bj * HALF; const size_t off = (size_t)row * DM + col;
                    const u32x4 pw = *(const u32x4*)(PROJ + off); const f32x4 h0 = *(const f32x4*)(H + off), h1 = *(const f32x4*)(H + off + 4);
                    const f32x4 g0 = acc[ai][bj][m][0] * rs, g1 = acc[ai][bj][m][1] * rs; f32x4 o0, o1;
                    o0[0] = h0[0] + fast_sigmoid(g0[0]) * bflo(pw.x); o0[1] = h0[1] + fast_sigmoid(g0[1]) * bfhi(pw.x); o0[2] = h0[2] + fast_sigmoid(g0[2]) * bflo(pw.y); o0[3] = h0[3] + fast_sigmoid(g0[3]) * bfhi(pw.y);
                    o1[0] = h1[0] + fast_sigmoid(g1[0]) * bflo(pw.z); o1[1] = h1[1] + fast_sigmoid(g1[1]) * bfhi(pw.z); o1[2] = h1[2] + fast_sigmoid(g1[2]) * bflo(pw.w); o1[3] = h1[3] + fast_sigmoid(g1[3]) * bfhi(pw.w);
                    if (row < MT) { float* yp = row < MP ? y_p + off : y_s + (size_t)(row - MP) * DM + col; *(f32x4*)yp = o0; *(f32x4*)(yp + 4) = o1; }
                    s += sumsq8(o0, o1); }
                ss[ai][m] = s; }
        rowsq_atomic(ss, rsq4, row0, fq);
    }
};
template <class Epi, class Sched, bool ALIGN_EPI = false, bool SP2 = false>
__device__ __forceinline__ void gemm_phase(PG8_LAS unsigned char* lds, const Gemm g, const Sched& S, const Epi& E) {
    int tid_ = threadIdx.x; asm volatile("" : "+v"(tid_));
    const int tid = tid_, wid = __builtin_amdgcn_readfirstlane(tid >> 6), lane = tid & 63, wr = wid >> 2, wc = wid & 3, fr = lane & 15, fq = lane >> 4;
    const int K = g.K, nt = K / BK;
    unsigned voffA[2], voffB[2];
#pragma unroll
    for (int i = 0; i < 2; ++i) { int R, C; stage_rc(tid * 16 + i * 8192, R, C); const int Rb = Epi::PERM ? ((R & ~31) + perm32(R & 31)) : R;
        voffA[i] = (unsigned)(R * g.lda + C) * 2u; voffB[i] = (unsigned)(Rb * g.ldb + C) * 2u; }
    const size_t kstep = (size_t)(BK * 2);
    const size_t hstepA = (size_t)HALF * g.lda * 2, hstepB = (size_t)HALF * g.ldb * 2;
    const size_t tstepA = 2 * hstepA, tstepB = 2 * hstepB;
    const unsigned ldsw = (unsigned)wid * 1024u;
    const int aoff = lds_byte(wr * 64 + fr, fq * 8), boff = lds_byte(wc * 32 + fr, fq * 8);
#define PG8_SA(b, h) (((b) * 2 + (h)) * HTB)
#define PG8_SB(b, h) ((4 + (b) * 2 + (h)) * HTB)
#define PG8_STAGE(bufoff, gbase, voff) do { _Pragma("unroll") for (int _i = 0; _i < 2; ++_i) \
        __builtin_amdgcn_global_load_lds((const unsigned*)((const char*)(gbase) + (voff)[_i]), (PG8_LAS unsigned*)(lds + (bufoff) + ldsw + _i * 8192), 16, 0, 0); } while (0)
#define PG8_LDA(dst, b, h) do { _Pragma("unroll") for (int m = 0; m < 4; ++m) _Pragma("unroll") for (int k = 0; k < 2; ++k) dst[m][k] = *(const PG8_LAS bf16x8*)(lds + PG8_SA(b, h) + aoff + m * 2048 + k * 1024); } while (0)
#define PG8_LDB(dst, b, h) do { _Pragma("unroll") for (int n = 0; n < 2; ++n) _Pragma("unroll") for (int k = 0; k < 2; ++k) dst[n][k] = *(const PG8_LAS bf16x8*)(lds + PG8_SB(b, h) + boff + n * 2048 + k * 1024); } while (0)
#define PG8_MMA(ai, bj, At, Bt) do { __builtin_amdgcn_s_setprio(1); _Pragma("unroll") for (int m = 0; m < 4; ++m) _Pragma("unroll") for (int n = 0; n < 2; ++n) _Pragma("unroll") for (int k = 0; k < 2; ++k) \
        acc[ai][bj][m][n] = __builtin_amdgcn_mfma_f32_16x16x32_bf16(Bt[n][k], At[m][k], acc[ai][bj][m][n], 0, 0, 0); __builtin_amdgcn_s_setprio(0); } while (0)
#define PG8_WAIT_V(n) asm volatile("s_waitcnt vmcnt(" #n ")" ::: "memory")
#define PG8_WAIT_L(n) asm volatile("s_waitcnt lgkmcnt(" #n ")" ::: "memory")
#define PG8_BAR __builtin_amdgcn_s_barrier()
#define PG8_SCHED __builtin_amdgcn_sched_barrier(0)
    Unit cur, nxt; int ui = 0;
    if (!S.next(0, cur)) return;
    f32x4 acc[2][2][4][2];
#pragma unroll
    for (int a = 0; a < 2; ++a)
#pragma unroll
        for (int b = 0; b < 2; ++b)
#pragma unroll
            for (int m = 0; m < 4; ++m)
#pragma unroll
                for (int n = 0; n < 2; ++n) acc[a][b][m][n] = (f32x4){0.f, 0.f, 0.f, 0.f};
    bf16x8 At[4][2], B0[2][2], B1[2][2];
    const char* cA = (const char*)g.A + (size_t)cur.pm * tstepA; const char* cB = (const char*)g.Bt + (size_t)cur.pn * tstepB;
    S.a_ready(cur);
    if constexpr (SP2) {
        PG8_STAGE(PG8_SB(0, 0), cB, voffB); PG8_STAGE(PG8_SB(0, 1), cB + hstepB, voffB); PG8_STAGE(PG8_SA(0, 0), cA, voffA); PG8_STAGE(PG8_SA(0, 1), cA + hstepA, voffA);
        if (wr == 1) PG8_BAR;
        PG8_WAIT_V(2); PG8_BAR;
        PG8_STAGE(PG8_SB(1, 0), cB + kstep, voffB); PG8_STAGE(PG8_SA(1, 0), cA + kstep, voffA); PG8_STAGE(PG8_SB(1, 1), cB + hstepB + kstep, voffB);
        PG8_WAIT_V(6); PG8_BAR;
    } else {
        PG8_STAGE(PG8_SB(0, 0), cB, voffB); PG8_STAGE(PG8_SA(0, 0), cA, voffA); PG8_STAGE(PG8_SB(0, 1), cB + hstepB, voffB); PG8_STAGE(PG8_SA(0, 1), cA + hstepA, voffA);
        if (wr == 1) PG8_BAR;
        PG8_WAIT_V(4); PG8_BAR;
        PG8_STAGE(PG8_SB(1, 0), cB + kstep, voffB); PG8_STAGE(PG8_SA(1, 0), cA + kstep, voffA); PG8_STAGE(PG8_SB(1, 1), cB + hstepB + kstep, voffB);
        PG8_WAIT_V(6); PG8_BAR;
    }
    for (;;) {
        const bool has_next = S.next(ui + 1, nxt);
        const char* nA = has_next ? (const char*)g.A + (size_t)nxt.pm * tstepA : cA; const char* nB = has_next ? (const char*)g.Bt + (size_t)nxt.pn * tstepB : cB;
#pragma nounroll
        for (int t = 0; t < nt; t += 2) {
            const bool last = (t == nt - 2);
            if constexpr (Epi::MIDSCALE) { if (t == (nt >> 1)) E.mid(acc, cur, wr, fr); }
            const char* a1 = cA + (size_t)(t + 1) * kstep;
            const char* a2 = last ? nA : cA + (size_t)(t + 2) * kstep; const char* b2 = last ? nB : cB + (size_t)(t + 2) * kstep;
            const char* a3 = a2 + kstep; const char* b3 = b2 + kstep;
            if (last && has_next) S.a_ready(nxt);
            if constexpr (SP2) {
            PG8_LDB(B0, 0, 0); PG8_LDB(B1, 0, 1); PG8_SCHED; PG8_LDA(At, 0, 0); PG8_STAGE(PG8_SA(1, 1), a1 + hstepA, voffA);
            PG8_WAIT_V(8); PG8_WAIT_L(0); PG8_BAR; PG8_MMA(0, 0, At, B0); PG8_MMA(0, 1, At, B1); PG8_BAR; PG8_SCHED;
            PG8_LDA(At, 0, 1); PG8_STAGE(PG8_SB(0, 0), b2, voffB); PG8_STAGE(PG8_SB(0, 1), b2 + hstepB, voffB); PG8_STAGE(PG8_SA(0, 0), a2, voffA);
            PG8_WAIT_V(8); PG8_WAIT_L(0); PG8_BAR; PG8_MMA(1, 0, At, B0); PG8_MMA(1, 1, At, B1); PG8_BAR; PG8_SCHED;
            PG8_LDB(B0, 1, 0); PG8_LDB(B1, 1, 1); PG8_SCHED; PG8_LDA(At, 1, 0); PG8_STAGE(PG8_SA(0, 1), a2 + hstepA, voffA);
            PG8_WAIT_V(8); PG8_WAIT_L(0); PG8_BAR; PG8_MMA(0, 0, At, B0); PG8_MMA(0, 1, At, B1); PG8_BAR; PG8_SCHED;
            PG8_LDA(At, 1, 1); PG8_STAGE(PG8_SB(1, 0), b3, voffB); PG8_STAGE(PG8_SB(1, 1), b3 + hstepB, voffB); PG8_STAGE(PG8_SA(1, 0), a3, voffA);
            PG8_WAIT_V(8); PG8_WAIT_L(0); PG8_BAR; PG8_MMA(1, 0, At, B0); PG8_MMA(1, 1, At, B1); PG8_BAR; PG8_SCHED;
            } else {
            PG8_LDB(B0, 0, 0); PG8_SCHED; PG8_LDA(At, 0, 0); PG8_STAGE(PG8_SA(1, 1), a1 + hstepA, voffA);
            PG8_WAIT_L(8); PG8_BAR; PG8_WAIT_L(0); PG8_MMA(0, 0, At, B0); PG8_BAR; PG8_SCHED;
            PG8_LDB(B1, 0, 1); PG8_STAGE(PG8_SB(0, 0), b2, voffB);
            PG8_BAR; PG8_WAIT_L(0); PG8_MMA(0, 1, At, B1); PG8_BAR;
            PG8_LDA(At, 0, 1); PG8_STAGE(PG8_SA(0, 0), a2, voffA);
            PG8_BAR; PG8_WAIT_L(0); PG8_MMA(1, 0, At, B0); PG8_BAR; PG8_SCHED;
            PG8_STAGE(PG8_SB(0, 1), b2 + hstepB, voffB);
            PG8_WAIT_V(6); PG8_BAR; PG8_MMA(1, 1, At, B1); PG8_BAR;
            PG8_LDB(B0, 1, 0); PG8_SCHED; PG8_LDA(At, 1, 0); PG8_STAGE(PG8_SA(0, 1), a2 + hstepA, voffA);
            PG8_WAIT_L(8); PG8_BAR; PG8_WAIT_L(0); PG8_MMA(0, 0, At, B0); PG8_BAR; PG8_SCHED;
            PG8_LDB(B1, 1, 1); PG8_STAGE(PG8_SB(1, 0), b3, voffB);
            PG8_BAR; PG8_WAIT_L(0); PG8_MMA(0, 1, At, B1); PG8_BAR;
            PG8_LDA(At, 1, 1); PG8_STAGE(PG8_SA(1, 0), a3, voffA);
            PG8_BAR; PG8_WAIT_L(0); PG8_MMA(1, 0, At, B0); PG8_BAR; PG8_SCHED;
            PG8_STAGE(PG8_SB(1, 1), b3 + hstepB, voffB);
            PG8_WAIT_V(6); PG8_BAR; PG8_MMA(1, 1, At, B1); PG8_BAR;
            }
        }
        if constexpr (ALIGN_EPI) { if (wr == 0) PG8_BAR; }
        if constexpr (!Epi::AFTER_DRAIN) { E(acc, cur, wr, wc, fr, fq); S.done(cur); }
        if (!has_next) break;
#pragma unroll
        for (int a = 0; a < 2; ++a)
#pragma unroll
            for (int b = 0; b < 2; ++b)
#pragma unroll
                for (int m = 0; m < 4; ++m)
#pragma unroll
                    for (int n = 0; n < 2; ++n) acc[a][b][m][n] = (f32x4){0.f, 0.f, 0.f, 0.f};
        cur = nxt; cA = nA; cB = nB; ++ui;
        if constexpr (ALIGN_EPI) { if (wr == 1) PG8_BAR; }
    }
    PG8_WAIT_V(0);
    if constexpr (!ALIGN_EPI) { if (wr == 0) PG8_BAR; }
    PG8_BAR;
    if constexpr (Epi::AFTER_DRAIN) { E.fused(acc, cur, wr, wc, fr, fq, lds, wid, lane); S.done(cur); }
#undef PG8_SA
#undef PG8_SB
#undef PG8_STAGE
#undef PG8_LDA
#undef PG8_LDB
#undef PG8_MMA
#undef PG8_WAIT_V
#undef PG8_WAIT_L
#undef PG8_BAR
#undef PG8_SCHED
}
}
namespace att {
using namespace fx;
constexpr int QBLK = 32, NW = 8, KVBLK = 64, QB_ROWS = QBLK * NW;
constexpr int QP = 768, KP = 768, VP = 512, OP = 1024;
constexpr float THR = 8.f;
constexpr int SHM_K = KVBLK * 256, SHM_V = KVBLK * 256;
constexpr int LDS_V = 0, LDS_K = 2 * SHM_V, LDS_WS = 2 * SHM_V + 2 * SHM_K, LDS_OST = LDS_WS + NW * 64 * 4, LDS_BYTES = LDS_OST + NW * 4096;
#define KSWZ(row, colB) ((row) * 256 + ((colB) ^ (((row) & 7) << 4)))
#define SBAR() __builtin_amdgcn_sched_barrier(0)
__device__ __forceinline__ int crow(int r, int hi) { return (r & 3) + 8 * (r >> 2) + 4 * hi; }
__device__ __forceinline__ unsigned cvtpk(float lo, float hi) { unsigned r; asm volatile("v_cvt_pk_bf16_f32 %0, %1, %2" : "=v"(r) : "v"(lo), "v"(hi)); return r; }
__device__ __forceinline__ void partialSM(f32x16& p0, f32x16& p1, float& m_reg, float& mn, float& alpha, bool band, int kbase, int qrow, int hi) {
    constexpr float C = ATT_SCALE * LOG2E;
    if (band) {
#pragma unroll
        for (int r = 0; r < 16; ++r) { const int kv = kbase + crow(r, hi); if (kv > qrow) p0[r] = -INFINITY; if (kv + 32 > qrow) p1[r] = -INFINITY; }
    }
    float pmax = p0[0];
#pragma unroll
    for (int r = 1; r < 16; ++r) pmax = fmaxf(pmax, p0[r]);
#pragma unroll
    for (int r = 0; r < 16; ++r) pmax = fmaxf(pmax, p1[r]);
    { auto rr = __builtin_amdgcn_permlane32_swap(__float_as_uint(pmax), __float_as_uint(pmax), false, false);
      pmax = fmaxf(__uint_as_float(rr[0]), __uint_as_float(rr[1])); }
    if (__builtin_expect(__all(pmax - m_reg <= THR / ATT_SCALE), 1)) { mn = m_reg; alpha = 1.f; }
    else { mn = fmaxf(m_reg, pmax); alpha = __builtin_amdgcn_exp2f((m_reg - mn) * C); m_reg = mn; }
    const float mnC = -mn * C;
#pragma unroll
    for (int r = 0; r < 16; ++r) p0[r] = fmaf(p0[r], C, mnC);
#pragma unroll
    for (int r = 0; r < 16; ++r) p1[r] = fmaf(p1[r], C, mnC);
#pragma unroll
    for (int r = 0; r < 16; ++r) p0[r] = __builtin_amdgcn_exp2f(p0[r]);
}
#define ATT_PK4(P, BASE, OUT) do { unsigned a0 = cvtpk(P[BASE + 0], P[BASE + 1]), a1 = cvtpk(P[BASE + 2], P[BASE + 3]);   \
    unsigned b0 = cvtpk(P[BASE + 4], P[BASE + 5]), b1 = cvtpk(P[BASE + 6], P[BASE + 7]);                              \
    auto r0 = __builtin_amdgcn_permlane32_swap(a0, b0, false, false); auto r1 = __builtin_amdgcn_permlane32_swap(a1, b1, false, false); \
    u32x4 w = {r0[0], r1[0], r0[1], r1[1]}; OUT = *reinterpret_cast<bf16x8*>(&w); } while (0)
__device__ __forceinline__ void finishSM(f32x16& p0, f32x16& p1, float alpha, float& l_reg, bf16x8& pa0, bf16x8& pa1, bf16x8& pa2, bf16x8& pa3) {
#pragma unroll
    for (int r = 0; r < 16; ++r) p1[r] = __builtin_amdgcn_exp2f(p1[r]);
    float ps = 0;
#pragma unroll
    for (int r = 0; r < 16; ++r) ps += p0[r];
#pragma unroll
    for (int r = 0; r < 16; ++r) ps += p1[r];
    { auto rr = __builtin_amdgcn_permlane32_swap(__float_as_uint(ps), __float_as_uint(ps), false, false);
      ps = __uint_as_float(rr[0]) + __uint_as_float(rr[1]); }
    l_reg = l_reg * alpha + ps;
    ATT_PK4(p0, 0, pa0); ATT_PK4(p0, 8, pa1); ATT_PK4(p1, 0, pa2); ATT_PK4(p1, 8, pa3);
}
template <int ND0> __device__ __forceinline__ void qkt(f32x16& p0, f32x16& p1, const char* Ks, const bf16x8* qr, int r32, int hi) {
    p0 = f32x16{}; p1 = f32x16{};
#pragma unroll
    for (int d0 = 0; d0 < ND0; ++d0) { const int cb = (d0 * 16 + hi * 8) * 2;
        const bf16x8 b0 = *reinterpret_cast<const bf16x8*>(Ks + KSWZ(r32, cb));
        const bf16x8 b1 = *reinterpret_cast<const bf16x8*>(Ks + KSWZ(32 + r32, cb));
        p0 = __builtin_amdgcn_mfma_f32_32x32x16_bf16(b0, qr[d0], p0, 0, 0, 0);
        p1 = __builtin_amdgcn_mfma_f32_32x32x16_bf16(b1, qr[d0], p1, 0, 0, 0); }
}
__device__ __forceinline__ int v_st(int k, int c) { const int kk = (k & ~0xC) | ((k & 4) << 1) | ((k & 8) >> 1); return ((kk >> 3) * 4 + (c >> 5)) * 512 + ((kk & 7) * 32 + (c & 31)) * 2; }
__device__ __forceinline__ int v_rd_base(int lane) { return ((lane & 3) << 3) | (((lane >> 2) & 3) << 6) | (((lane >> 4) & 1) << 5) | (((lane >> 5) & 1) << 8); }
constexpr int v_rd_off(int d0, int ks, int half) { return d0 * 512 + ks * 4096 + half * 2048; }
template <int OFF> __device__ __forceinline__ s16x4 tr_read(int vb) {
    s16x4 r; asm volatile("ds_read_b64_tr_b16 %0, %1 offset:%2" : "=&v"(r) : "v"(vb), "i"(OFF) : "memory"); return r;
}
#define ATT_PK(L, H) (bf16x8){L[0], L[1], L[2], L[3], H[0], H[1], H[2], H[3]}
template <int D0> __device__ __forceinline__ void pv_one(f32x16& od, int vb, bf16x8 pa0, bf16x8 pa1, bf16x8 pa2, bf16x8 pa3) {
    const s16x4 l0 = tr_read<v_rd_off(D0, 0, 0)>(vb), h0 = tr_read<v_rd_off(D0, 0, 1)>(vb), l1 = tr_read<v_rd_off(D0, 1, 0)>(vb), h1 = tr_read<v_rd_off(D0, 1, 1)>(vb);
    const s16x4 l2 = tr_read<v_rd_off(D0, 2, 0)>(vb), h2 = tr_read<v_rd_off(D0, 2, 1)>(vb), l3 = tr_read<v_rd_off(D0, 3, 0)>(vb), h3 = tr_read<v_rd_off(D0, 3, 1)>(vb);
    asm volatile("s_waitcnt lgkmcnt(0)" ::: "memory"); SBAR();
    od = __builtin_amdgcn_mfma_f32_32x32x16_bf16(pa0, ATT_PK(l0, h0), od, 0, 0, 0);
    od = __builtin_amdgcn_mfma_f32_32x32x16_bf16(pa1, ATT_PK(l1, h1), od, 0, 0, 0);
    od = __builtin_amdgcn_mfma_f32_32x32x16_bf16(pa2, ATT_PK(l2, h2), od, 0, 0, 0);
    od = __builtin_amdgcn_mfma_f32_32x32x16_bf16(pa3, ATT_PK(l3, h3), od, 0, 0, 0);
}
__device__ __forceinline__ void attn_unit(int b, int h, int qb, const bf16_t* __restrict__ Q, const bf16_t* __restrict__ K, const bf16_t* __restrict__ V,
                                          bf16_t* __restrict__ O, float* __restrict__ rsqa, char* lds) {
    int tid_ = threadIdx.x; asm volatile("" : "+v"(tid_));
    const int tid = tid_, wid = tid >> 6, lane = tid & 63, r32 = lane & 31, hi = lane >> 5;
    const long rowbase = (long)b * S; const int q0 = qb * QB_ROWS;
    char* V_lds = lds + LDS_V; char* K_lds = lds + LDS_K;
    float* ws = (float*)(lds + LDS_WS) + wid * 64; float* li_l = ws; float* al_l = ws + 32;
    const bf16_t* Kh = K + rowbase * KP + h * 96; const bf16_t* Vh = V + rowbase * VP + h * 64;
    float m_reg = -1e30f, l_reg = 0; f32x16 o[2] = {}; bf16x8 qr[6];
    const bf16_t* Qw = Q + (rowbase + q0 + wid * QBLK + r32) * QP + h * 96 + hi * 8;
#pragma unroll
    for (int d0 = 0; d0 < 6; ++d0) qr[d0] = *reinterpret_cast<const bf16x8*>(Qw + d0 * 16);
    const int srA = tid >> 3, scA = tid & 7, srB = (tid & 255) >> 2, scB = 8 + (tid & 3);
    const int kstA = KSWZ(srA, scA * 16), kstB = KSWZ(srB, scB * 16), vst = v_st(srA, scA * 8);
    const int vb0 = (int)(uintptr_t)V_lds + v_rd_base(lane);
    bf16x8 ka[2], kb[2], vv[2];
#define SLOAD(i, k0) do { ka[i] = *reinterpret_cast<const bf16x8*>(Kh + (long)((k0) + srA) * KP + scA * 8); kb[i] = *reinterpret_cast<const bf16x8*>(Kh + (long)((k0) + srB) * KP + scB * 8); \
    vv[i] = *reinterpret_cast<const bf16x8*>(Vh + (long)((k0) + srA) * VP + scA * 8); } while (0)
#define SWRITE(bf, i) do { *(bf16x8*)(K_lds + (bf) * SHM_K + kstA) = ka[i]; *(bf16x8*)(K_lds + (bf) * SHM_K + kstB) = kb[i]; *(bf16x8*)(V_lds + (bf) * SHM_V + vst) = vv[i]; } while (0)
#define RESC(a) do { if (__any((a) < 1.f)) { if (hi == 0) al_l[r32] = (a); asm volatile("s_waitcnt lgkmcnt(0)" ::: "memory"); \
    _Pragma("unroll") for (int d = 0; d < 2; ++d) _Pragma("unroll") for (int r = 0; r < 16; ++r) o[d][r] *= al_l[crow(r, hi)]; } } while (0)
    f32x16 pA0, pA1, pB0, pB1; float mnA, mnB, alA, alB; bf16x8 pa0, pa1, pa2, pa3;
    const int NT = (q0 + QB_ROWS) / KVBLK;
    const int qrow = q0 + wid * QBLK + r32;
    constexpr int SE = 0, SO = 1;
    SLOAD(SE, 0); asm volatile("s_waitcnt vmcnt(0)" ::: "memory"); SWRITE(0, SE); __syncthreads();
    qkt<6>(pA0, pA1, K_lds, qr, r32, hi); partialSM(pA0, pA1, m_reg, mnA, alA, NT <= 4, 0, qrow, hi);
    SLOAD(SO, KVBLK); if (2 < NT) SLOAD(SE, 2 * KVBLK);
    SWRITE(1, SO); __syncthreads();
    for (int j = 1; j + 1 < NT; j += 2) {
        SBAR(); qkt<6>(pB0, pB1, K_lds + SHM_K, qr, r32, hi);
        finishSM(pA0, pA1, alA, l_reg, pa0, pa1, pa2, pa3); SBAR();
        SLOAD(SO, (j + 2) * KVBLK); SBAR();
        pv_one<0>(o[0], vb0, pa0, pa1, pa2, pa3); pv_one<1>(o[1], vb0, pa0, pa1, pa2, pa3);
        partialSM(pB0, pB1, m_reg, mnB, alB, j >= NT - 4, j * KVBLK, qrow, hi);
        __syncthreads(); SWRITE(0, SE);
        RESC(alB); __syncthreads();
        SBAR(); qkt<6>(pA0, pA1, K_lds, qr, r32, hi);
        finishSM(pB0, pB1, alB, l_reg, pa0, pa1, pa2, pa3); SBAR();
        if (j + 3 < NT) SLOAD(SE, (j + 3) * KVBLK); SBAR();
        pv_one<0>(o[0], vb0 + SHM_V, pa0, pa1, pa2, pa3); pv_one<1>(o[1], vb0 + SHM_V, pa0, pa1, pa2, pa3);
        partialSM(pA0, pA1, m_reg, mnA, alA, j + 1 >= NT - 4, (j + 1) * KVBLK, qrow, hi);
        __syncthreads(); SWRITE(1, SO);
        RESC(alA); __syncthreads();
    }
    SBAR(); qkt<6>(pB0, pB1, K_lds + SHM_K, qr, r32, hi);
    finishSM(pA0, pA1, alA, l_reg, pa0, pa1, pa2, pa3); SBAR();
    pv_one<0>(o[0], vb0, pa0, pa1, pa2, pa3); pv_one<1>(o[1], vb0, pa0, pa1, pa2, pa3);
    partialSM(pB0, pB1, m_reg, mnB, alB, true, (NT - 1) * KVBLK, qrow, hi);
    __syncthreads(); RESC(alB);
    finishSM(pB0, pB1, alB, l_reg, pa0, pa1, pa2, pa3); SBAR();
    pv_one<0>(o[0], vb0 + SHM_V, pa0, pa1, pa2, pa3); pv_one<1>(o[1], vb0 + SHM_V, pa0, pa1, pa2, pa3);
    if (hi == 0) li_l[r32] = l_reg; asm volatile("s_waitcnt lgkmcnt(0)" ::: "memory");
    float rli[16];
#pragma unroll
    for (int r = 0; r < 16; ++r) rli[r] = __builtin_amdgcn_rcpf(li_l[crow(r, hi)]);
    int zo = 0; asm volatile("" : "+v"(zo));
    bf16_t* stg = (bf16_t*)(lds + LDS_OST) + wid * 2048 + zo;
#pragma unroll
    for (int r = 0; r < 16; ++r) { const int orow = crow(r, hi);
#pragma unroll
        for (int d0 = 0; d0 < 2; ++d0) { const float v = o[d0][r] * rli[r]; stg[orow * 64 + d0 * 32 + r32] = (bf16_t)(cvtpk(v, v) & 0xffffu); } }
    asm volatile("s_waitcnt lgkmcnt(0)" ::: "memory");
    bf16_t* Ow = O + (rowbase + q0 + wid * QBLK) * OP + h * 64 + zo;
#pragma unroll
    for (int i = 0; i < 4; ++i) { const int row = i * 8 + (lane >> 3), ch = lane & 7; const u32x4 v = *(const u32x4*)(stg + row * 64 + ch * 8);
        *(u32x4*)(Ow + (long)row * OP + ch * 8) = v;
        float s = bflo(v.x) * bflo(v.x) + bfhi(v.x) * bfhi(v.x) + bflo(v.y) * bflo(v.y) + bfhi(v.y) * bfhi(v.y) + bflo(v.z) * bflo(v.z) + bfhi(v.z) * bfhi(v.z) + bflo(v.w) * bflo(v.w) + bfhi(v.w) * bfhi(v.w);
        s += __shfl_xor(s, 1); s += __shfl_xor(s, 2); s += __shfl_xor(s, 4);
        if (ch == 0) unsafeAtomicAdd(rsqa + rowbase + q0 + wid * QBLK + row, s); }
    __syncthreads();
#undef SLOAD
#undef SWRITE
#undef RESC
}
}
namespace ml {
using namespace fx;
using att::crow; using att::v_st; using att::v_rd_base; using att::v_rd_off; using att::tr_read; using att::cvtpk;
constexpr int NCH = S / 128, NUNIT = NB * MH * NCH;
struct Small { float lf[128], ig[128], at[128], cm[128], bt[128], ws[128], nn[128], red[256]; float sc[8]; };
static_assert(sizeof(Small) <= 8192, "Small");
__device__ __forceinline__ void chunk_gates(LAS Small* sm, const float* __restrict__ GATES, const float* __restrict__ b_i, const float* __restrict__ b_f, long row0, int h, int ltid) {
    if (ltid < 128) { const float* g = GATES + (row0 + ltid) * 8; sm->ig[ltid] = g[h] + b_i[h]; sm->lf[ltid] = log_sigmoid(g[4 + h] + b_f[h]); }
    __syncthreads();
    if (ltid == 0) { float b = 0.f, am = -INFINITY;
        for (int t = 0; t < 128; ++t) { b += sm->lf[t]; const float a = sm->ig[t] - b; am = fmaxf(am, a); sm->bt[t] = b; sm->at[t] = a; sm->cm[t] = am; }
        sm->sc[0] = am; sm->sc[1] = b; }
    __syncthreads();
}
__device__ __forceinline__ bf16x8 scale8(bf16x8 v, float w) {
    const u32x4 x = __builtin_bit_cast(u32x4, v); u32x4 y;
    y.x = cvt_pk_bf16(bflo(x.x) * w, bfhi(x.x) * w); y.y = cvt_pk_bf16(bflo(x.y) * w, bfhi(x.y) * w); y.z = cvt_pk_bf16(bflo(x.z) * w, bfhi(x.z) * w); y.w = cvt_pk_bf16(bflo(x.w) * w, bfhi(x.w) * w);
    return __builtin_bit_cast(bf16x8, y);
}
__device__ __forceinline__ void local_pair(int pr, const bf16_t* __restrict__ MK, const bf16_t* __restrict__ MV, const float* __restrict__ GATES, const float* __restrict__ b_i, const float* __restrict__ b_f,
                                           float* __restrict__ DCT, float* __restrict__ DN, float* __restrict__ ALAST, float* __restrict__ BL, char* lds, LAS Small* smb) {
    int tid_ = threadIdx.x; asm volatile("" : "+v"(tid_));
    const int tid = tid_, wid = tid >> 6, lane = tid & 63, r32 = lane & 31, hi = lane >> 5, hb = wid >> 2, w4 = wid & 3, ltid = tid & 255;
    const int u = 2 * pr + hb, bh = u >> 6, c = u & 63, b = bh >> 2, h = bh & 3;
    const long row0 = (long)b * S + c * 128;
    LAS Small* sm = smb + hb;
    char* Kimg = lds + hb * 65536; char* Vimg = Kimg + 32768;
    chunk_gates(sm, GATES, b_i, b_f, row0, h, ltid);
    const float alast = sm->sc[0];
    if (ltid < 128) sm->ws[ltid] = __expf(sm->at[ltid] - alast);
    if (ltid == 0) { ALAST[u] = alast; BL[u] = sm->sc[1]; }
    __syncthreads();
    { const int ch = ltid & 15;
#pragma unroll
      for (int i = 0; i < 8; ++i) { const int r = (ltid >> 4) + 16 * i; const size_t g = (size_t)(row0 + r) * 512 + h * 128 + ch * 8;
          const bf16x8 kv = *reinterpret_cast<const bf16x8*>(MK + g), vv = *reinterpret_cast<const bf16x8*>(MV + g);
          const int off = (r >> 6) * 16384 + v_st(r & 63, ch * 8);
          *(bf16x8*)(Kimg + off) = scale8(kv, sm->ws[r]); *(bf16x8*)(Vimg + off) = vv; } }
    __syncthreads();
    f32x16 acc[4] = {};
    const int vbV = (int)(uintptr_t)Vimg + v_rd_base(lane) + w4 * 512, vbK = (int)(uintptr_t)Kimg + v_rd_base(lane);
#define ML_STEP(T, KS) do { const int tv = vbV + (T) * 16384, tk = vbK + (T) * 16384; \
        const s16x4 al = tr_read<v_rd_off(0, KS, 0)>(tv), ah = tr_read<v_rd_off(0, KS, 1)>(tv); \
        const s16x4 b0l = tr_read<v_rd_off(0, KS, 0)>(tk), b0h = tr_read<v_rd_off(0, KS, 1)>(tk), b1l = tr_read<v_rd_off(1, KS, 0)>(tk), b1h = tr_read<v_rd_off(1, KS, 1)>(tk); \
        const s16x4 b2l = tr_read<v_rd_off(2, KS, 0)>(tk), b2h = tr_read<v_rd_off(2, KS, 1)>(tk), b3l = tr_read<v_rd_off(3, KS, 0)>(tk), b3h = tr_read<v_rd_off(3, KS, 1)>(tk); \
        asm volatile("s_waitcnt lgkmcnt(0)" ::: "memory"); __builtin_amdgcn_sched_barrier(0); \
        const bf16x8 A = ATT_PK(al, ah); \
        acc[0] = __builtin_amdgcn_mfma_f32_32x32x16_bf16(A, ATT_PK(b0l, b0h), acc[0], 0, 0, 0); acc[1] = __builtin_amdgcn_mfma_f32_32x32x16_bf16(A, ATT_PK(b1l, b1h), acc[1], 0, 0, 0); \
        acc[2] = __builtin_amdgcn_mfma_f32_32x32x16_bf16(A, ATT_PK(b2l, b2h), acc[2], 0, 0, 0); acc[3] = __builtin_amdgcn_mfma_f32_32x32x16_bf16(A, ATT_PK(b3l, b3h), acc[3], 0, 0, 0); } while (0)
    ML_STEP(0, 0); ML_STEP(0, 1); ML_STEP(0, 2); ML_STEP(0, 3); ML_STEP(1, 0); ML_STEP(1, 1); ML_STEP(1, 2); ML_STEP(1, 3);
#undef ML_STEP
    float* dct = DCT + (size_t)u * 16384;
#pragma unroll
    for (int d = 0; d < 4; ++d)
#pragma unroll
        for (int r = 0; r < 16; ++r) dct[(32 * w4 + crow(r, hi)) * 128 + 32 * d + r32] = acc[d][r];
    { const int dk = ltid & 127, hs = ltid >> 7; float s = 0.f;
      for (int k = 0; k < 64; ++k) s += bf2f(*(const bf16_t*)(Kimg + hs * 16384 + v_st(k, dk)));
      sm->red[ltid] = s; }
    __syncthreads();
    if (ltid < 128) DN[(size_t)u * 128 + ltid] = sm->red[ltid] + sm->red[128 + ltid];
    __syncthreads();
}
__device__ __forceinline__ void scan_all(int vcu, int G, const float* __restrict__ DCT, const float* __restrict__ DN, const float* __restrict__ ALAST, const float* __restrict__ BL,
                                         bf16_t* __restrict__ CT, float* __restrict__ NST, float* __restrict__ MST, float* __restrict__ C_p, float* __restrict__ n_p, float* __restrict__ m_p) {
    int tid_ = threadIdx.x; asm volatile("" : "+v"(tid_));
    for (int e = vcu * 512 + tid_; e < NB * MH * 16384; e += G * 512) {
        const int bh = e >> 14, idx = e & 16383, dv = idx >> 7, dk = idx & 127;
        float C = 0.f, n = 0.f, m = 0.f; const bool do_n = idx < 128, do_m = idx == 0;
        for (int c0 = 0; c0 < NCH; c0 += 8) {
            float d[8], dn[8];
#pragma unroll
            for (int j = 0; j < 8; ++j) { d[j] = DCT[(size_t)(bh * 64 + c0 + j) * 16384 + idx]; dn[j] = do_n ? DN[(size_t)(bh * 64 + c0 + j) * 128 + idx] : 0.f; }
#pragma unroll
            for (int j = 0; j < 8; ++j) { const int u = bh * 64 + c0 + j; const float al = ALAST[u], bl = BL[u];
                CT[(size_t)u * 16384 + idx] = (bf16_t)(cvt_pk_bf16(C, C) & 0xffffu);
                if (do_n) NST[(size_t)u * 128 + idx] = n;
                if (do_m) MST[u] = m;
                const float M = fmaxf(m, al), f1 = __expf(m - M), f2 = __expf(al - M);
                C = f1 * C + f2 * d[j]; n = f1 * n + f2 * dn[j]; m = bl + M; }
        }
        C_p[(size_t)bh * 16384 + dk * 128 + dv] = C;
        if (do_n) n_p[bh * 128 + idx] = n;
        if (do_m) m_p[bh] = m;
    }
}
__device__ __forceinline__ void out_pair(int pr, const bf16_t* __restrict__ MQ, const bf16_t* __restrict__ MK, const bf16_t* __restrict__ MV, const bf16_t* __restrict__ MO,
                                         const float* __restrict__ GATES, const float* __restrict__ b_i, const float* __restrict__ b_f,
                                         const bf16_t* __restrict__ CT, const float* __restrict__ NST, const float* __restrict__ MST, bf16_t* __restrict__ AB, char* lds, LAS Small* smb) {
    int tid_ = threadIdx.x; asm volatile("" : "+v"(tid_));
    const int tid = tid_, wid = tid >> 6, lane = tid & 63, r32 = lane & 31, hi = lane >> 5, hb = wid >> 2, w4 = wid & 3, ltid = tid & 255;
    const int u = 2 * pr + hb, bh = u >> 6, c = u & 63, b = bh >> 2, h = bh & 3;
    const long row0 = (long)b * S + c * 128;
    LAS Small* sm = smb + hb;
    char* Kimg = lds + hb * 65536; char* Vimg = Kimg + 32768;
    chunk_gates(sm, GATES, b_i, b_f, row0, h, ltid);
    const float mc = MST[u];
    if (ltid < 128) { const float M = fmaxf(mc, sm->cm[ltid]); sm->cm[ltid] = M; sm->ws[ltid] = __expf(mc - M); sm->bt[ltid] += M; sm->nn[ltid] = NST[(size_t)u * 128 + ltid]; }
    { const int ch = ltid & 15;
#pragma unroll
      for (int i = 0; i < 8; ++i) { const int r = (ltid >> 4) + 16 * i; const size_t g = (size_t)(row0 + r) * 512 + h * 128 + ch * 8;
          const bf16x8 kv = *reinterpret_cast<const bf16x8*>(MK + g), vv = *reinterpret_cast<const bf16x8*>(MV + g);
          *(bf16x8*)(Kimg + KSWZ(r, ch * 16)) = kv; *(bf16x8*)(Vimg + (r >> 6) * 16384 + v_st(r & 63, ch * 8)) = vv; } }
    const int t = 32 * w4 + r32;
    bf16x8 qr[8];
    { const bf16_t* qp = MQ + (size_t)(row0 + t) * 512 + h * 128 + hi * 8;
#pragma unroll
      for (int d0 = 0; d0 < 8; ++d0) qr[d0] = *reinterpret_cast<const bf16x8*>(qp + d0 * 16); }
    __syncthreads();
    const float Mt = sm->cm[t], wint = sm->ws[t], mrow = sm->bt[t];
    f32x16 o[4] = {}; float rsum = 0.f;
    const int vbV = (int)(uintptr_t)Vimg + v_rd_base(lane);
    for (int j = 0; j <= (w4 >> 1); ++j) {
        f32x16 p0, p1; att::qkt<8>(p0, p1, Kimg + j * 16384, qr, r32, hi);
#pragma unroll
        for (int r = 0; r < 16; ++r) { const int s0 = 64 * j + crow(r, hi);
            const float e0 = (s0 <= t) ? __builtin_amdgcn_exp2f((sm->at[s0] - Mt) * LOG2E) : 0.f, e1 = (s0 + 32 <= t) ? __builtin_amdgcn_exp2f((sm->at[s0 + 32] - Mt) * LOG2E) : 0.f;
            p0[r] *= e0; p1[r] *= e1; rsum += p0[r] + p1[r]; }
        bf16x8 pa0, pa1, pa2, pa3;
        ATT_PK4(p0, 0, pa0); ATT_PK4(p0, 8, pa1); ATT_PK4(p1, 0, pa2); ATT_PK4(p1, 8, pa3);
        const int vb = vbV + j * 16384;
        att::pv_one<0>(o[0], vb, pa0, pa1, pa2, pa3); att::pv_one<1>(o[1], vb, pa0, pa1, pa2, pa3); att::pv_one<2>(o[2], vb, pa0, pa1, pa2, pa3); att::pv_one<3>(o[3], vb, pa0, pa1, pa2, pa3);
    }
    float qn = 0.f;
    __syncthreads();
    { const int ch = ltid & 15; const bf16_t* ctg = CT + (size_t)u * 16384;
#pragma unroll
      for (int i = 0; i < 8; ++i) { const int r = (ltid >> 4) + 16 * i; *(bf16x8*)(Kimg + KSWZ(r, ch * 16)) = *reinterpret_cast<const bf16x8*>(ctg + (size_t)r * 128 + ch * 8); if (i == 3) asm volatile("" ::: "memory"); } }
    __syncthreads();
#pragma unroll
    for (int ks = 0; ks < 8; ++ks) {
        const u32x4 x = __builtin_bit_cast(u32x4, qr[ks]);
        const float q0 = bflo(x.x), q1 = bfhi(x.x), q2 = bflo(x.y), q3 = bfhi(x.y), q4 = bflo(x.z), q5 = bfhi(x.z), q6 = bflo(x.w), q7 = bfhi(x.w);
        const int kb = 16 * ks + 8 * hi;
        qn += q0 * sm->nn[kb] + q1 * sm->nn[kb + 1] + q2 * sm->nn[kb + 2] + q3 * sm->nn[kb + 3] + q4 * sm->nn[kb + 4] + q5 * sm->nn[kb + 5] + q6 * sm->nn[kb + 6] + q7 * sm->nn[kb + 7];
        u32x4 y; y.x = cvt_pk_bf16(q0 * wint, q1 * wint); y.y = cvt_pk_bf16(q2 * wint, q3 * wint); y.z = cvt_pk_bf16(q4 * wint, q5 * wint); y.w = cvt_pk_bf16(q6 * wint, q7 * wint);
        const bf16x8 qs = __builtin_bit_cast(bf16x8, y);
        const int cb = (ks * 16 + hi * 8) * 2;
#pragma unroll
        for (int d0 = 0; d0 < 4; ++d0) { const bf16x8 bfr = *reinterpret_cast<const bf16x8*>(Kimg + KSWZ(32 * d0 + r32, cb));
            o[d0] = __builtin_amdgcn_mfma_f32_32x32x16_bf16(qs, bfr, o[d0], 0, 0, 0); } }
    { auto rr = __builtin_amdgcn_permlane32_swap(__float_as_uint(rsum), __float_as_uint(rsum), false, false); rsum = __uint_as_float(rr[0]) + __uint_as_float(rr[1]); }
    { auto rr = __builtin_amdgcn_permlane32_swap(__float_as_uint(qn), __float_as_uint(qn), false, false); qn = __uint_as_float(rr[0]) + __uint_as_float(rr[1]); }
    const float den = fmaxf(fabsf(rsum + qn * wint), __expf(-mrow));
    LAS float* li = sm->red + w4 * 32;
    __syncthreads();
    if (hi == 0) li[r32] = 1.f / den;
    asm volatile("s_waitcnt lgkmcnt(0)" ::: "memory");
    int zo = 0; asm volatile("" : "+v"(zo));
    const bf16_t* mo = MO + (size_t)row0 * 512 + h * 128 + zo; bf16_t* ab = AB + (size_t)row0 * DM + 512 + h * 128 + zo;
#pragma unroll
    for (int r = 0; r < 16; ++r) { const int tr = 32 * w4 + crow(r, hi); const float rl = li[crow(r, hi)]; float ss = 0.f; float hv[4];
#pragma unroll
        for (int d0 = 0; d0 < 4; ++d0) { const float og = bf2f(mo[(size_t)tr * 512 + 32 * d0 + r32]); hv[d0] = o[d0][r] * rl * fast_sigmoid(og); ss += hv[d0] * hv[d0]; }
        ss += __shfl_xor(ss, 1); ss += __shfl_xor(ss, 2); ss += __shfl_xor(ss, 4); ss += __shfl_xor(ss, 8); ss += __shfl_xor(ss, 16);
        const float rs = rsqrtf(ss * (1.f / 128.f) + EPS);
#pragma unroll
        for (int d0 = 0; d0 < 4; ++d0) { const float v = hv[d0] * rs; ab[(size_t)tr * DM + 32 * d0 + r32] = (bf16_t)(cvt_pk_bf16(v, v) & 0xffffu); } }
    __syncthreads();
}
__device__ __forceinline__ void sample_step(int u, const bf16_t* __restrict__ MQ, const bf16_t* __restrict__ MK, const bf16_t* __restrict__ MV, const bf16_t* __restrict__ MO,
                                            const float* __restrict__ GATES, const float* __restrict__ b_i, const float* __restrict__ b_f,
                                            const float* __restrict__ sC, const float* __restrict__ sn, const float* __restrict__ smst,
                                            float* __restrict__ C_s, float* __restrict__ n_s, float* __restrict__ m_s, bf16_t* __restrict__ AB, LAS float* f  ) {
    int tid_ = threadIdx.x; asm volatile("" : "+v"(tid_)); const int tid = tid_, dv = tid & 127, part = tid >> 7, bs = u >> 2, h = u & 3;
    const size_t row = (size_t)MP + bs, g = row * 512 + h * 128;
    LAS float* qs = f; LAS float* ks = f + 128; LAS float* vs = f + 256; LAS float* nn = f + 384; LAS float* red = f + 512;
    if (tid < 128) { qs[tid] = bf2f(MQ[g + tid]); nn[tid] = sn[(size_t)u * 128 + tid]; } else if (tid < 256) ks[tid - 128] = bf2f(MK[g + tid - 128]); else if (tid < 384) vs[tid - 256] = bf2f(MV[g + tid - 256]);
    const float ig = GATES[row * 8 + h] + b_i[h], lf = log_sigmoid(GATES[row * 8 + 4 + h] + b_f[h]), m0 = smst[u];
    const float mnew = fmaxf(lf + m0, ig), a = __expf(lf + m0 - mnew), w = __expf(ig - mnew);
    __syncthreads();
    const float wv = w * vs[dv]; float pn = 0.f;
    const float* c0 = sC + (size_t)u * 16384 + (size_t)(part * 32) * 128 + dv; float* c1 = C_s + (size_t)u * 16384 + (size_t)(part * 32) * 128 + dv;
#pragma unroll 8
    for (int i = 0; i < 32; ++i) { const int dk = part * 32 + i; const float cn = fmaf(a, c0[(size_t)i * 128], wv * ks[dk]); c1[(size_t)i * 128] = cn; pn = fmaf(qs[dk], cn, pn); }
    red[part * 128 + dv] = pn;
    float nnew = 0.f;
    if (tid < 128) { nnew = fmaf(a, nn[tid], w * ks[tid]); n_s[(size_t)u * 128 + tid] = nnew; }
    __syncthreads();
    if (tid < 128) nn[tid] = nnew;
    if (tid == 0) m_s[u] = mnew;
    __syncthreads();
    float hv = 0.f;
    if (part == 0) { float qn = 0.f;
        for (int d = 0; d < 128; ++d) qn = fmaf(qs[d], nn[d], qn);
        const float den = fmaxf(fabsf(qn), __expf(-mnew)), num = red[dv] + red[128 + dv] + red[256 + dv] + red[384 + dv];
        hv = num / den * fast_sigmoid(bf2f(MO[g + dv])); }
    __syncthreads();
    if (part == 0) vs[dv] = hv;
    __syncthreads();
    if (part == 0) { float ss = 0.f;
        for (int d = 0; d < 128; ++d) ss = fmaf(vs[d], vs[d], ss);
        const float v = hv * rsqrtf(ss * (1.f / 128.f) + EPS);
        AB[row * DM + 512 + h * 128 + dv] = (bf16_t)(cvt_pk_bf16(v, v) & 0xffffu); }
    __syncthreads();
}
}
namespace sa {
using namespace fx;
constexpr int NSPLIT = 4, PG_PER_UNIT = NPAGE / NSPLIT, NUNIT = MS * NSPLIT;
constexpr int TPITCH = 544, TILE_BYTES = 32 * TPITCH;
constexpr int PART_STRIDE = 8 * 256 + 16;
typedef float f32x4 __attribute__((ext_vector_type(4)));
__device__ __forceinline__ void qabs_unit(int bs, const bf16_t* __restrict__ QB, const float* __restrict__ w_uk, bf16_t* __restrict__ QABS, LAS float* f) {
    int tid_ = threadIdx.x; asm volatile("" : "+v"(tid_)); const int tid = tid_;
    f[tid] = bf2f(QB[(size_t)(MP + bs) * 768 + (tid >> 6) * 96 + (tid & 63)]);
    __syncthreads();
    const int c = tid & 255, hh = tid >> 8;
#pragma unroll
    for (int k = 0; k < 4; ++k) { const int h = hh * 4 + k; const float* w = w_uk + (size_t)c * 512 + h * 64; float s = 0.f;
#pragma unroll 8
        for (int n = 0; n < 64; n += 4) { const f32x4 wv = *(const f32x4*)(w + n); s += f[h * 64 + n] * wv[0] + f[h * 64 + n + 1] * wv[1] + f[h * 64 + n + 2] * wv[2] + f[h * 64 + n + 3] * wv[3]; }
        QABS[(size_t)(bs * 8 + h) * 256 + c] = (bf16_t)(cvt_pk_bf16(s, s) & 0xffffu); }
    __syncthreads();
}
__device__ __forceinline__ bf16x8 cvt8(f32x4 a, f32x4 b) { u32x4 w; w.x = cvt_pk_bf16(a[0], a[1]); w.y = cvt_pk_bf16(a[2], a[3]); w.z = cvt_pk_bf16(b[0], b[1]); w.w = cvt_pk_bf16(b[2], b[3]); return __builtin_bit_cast(bf16x8, w); }
__device__ __forceinline__ s16x4 tr_read_dyn(int addr) { s16x4 r; asm volatile("ds_read_b64_tr_b16 %0, %1" : "=&v"(r) : "v"(addr) : "memory"); return r; }
__device__ __forceinline__ void part_unit(int un, const bf16_t* __restrict__ QB, const bf16_t* __restrict__ QABS, const float* __restrict__ cache_c, const float* __restrict__ cache_r,
                                          const int* __restrict__ pt, float* __restrict__ PART, char* lds) {
    int tid_ = threadIdx.x; asm volatile("" : "+v"(tid_)); const int tid = tid_, wid = tid >> 6, lane = tid & 63, l16 = lane & 15, g = lane >> 4;
    const int bs = un / NSPLIT, sp = un % NSPLIT;
    char* tile = lds + wid * TILE_BYTES; const int tile_a = (int)(uintptr_t)tile;
    bf16x8 qa[8], qrp;
    if (l16 < 8) {
#pragma unroll
        for (int ks = 0; ks < 8; ++ks) qa[ks] = *reinterpret_cast<const bf16x8*>(QABS + (size_t)(bs * 8 + l16) * 256 + 32 * ks + 8 * g);
        qrp = *reinterpret_cast<const bf16x8*>(QB + (size_t)(MP + bs) * 768 + l16 * 96 + 64 + 8 * g);
    } else {
#pragma unroll
        for (int ks = 0; ks < 8; ++ks) qa[ks] = (bf16x8){0, 0, 0, 0, 0, 0, 0, 0};
        qrp = (bf16x8){0, 0, 0, 0, 0, 0, 0, 0};
    }
    float m = -1e30f, l = 0.f; f32x4 o[16];
#pragma unroll
    for (int cb = 0; cb < 16; ++cb) o[cb] = (f32x4){0.f, 0.f, 0.f, 0.f};
    constexpr float C = ATT_SCALE * LOG2E;
    const int wr_off = l16 * TPITCH + 16 * g;
    const int rd_lo = tile_a + (4 * g + (l16 >> 2)) * TPITCH + (l16 & 3) * 8;
    for (int pgi = 0; pgi < 2; ++pgi) {
        const int pg = pt[bs * NPAGE + sp * PG_PER_UNIT + wid * 2 + pgi];
        const float* cpg = cache_c + (size_t)pg * PAGE * KVL; const float* rpg = cache_r + (size_t)pg * PAGE * RD;
        for (int k0 = 0; k0 < PAGE; k0 += 32) {
            f32x4 s[2];
#pragma unroll
            for (int hf = 0; hf < 2; ++hf) { const int key = k0 + 16 * hf + l16;
                const float* cp = cpg + (size_t)key * KVL + 8 * g; const float* rp = rpg + (size_t)key * RD + 8 * g;
                const f32x4 r0 = *(const f32x4*)rp, r1 = *(const f32x4*)(rp + 4);
                f32x4 acc = (f32x4){0.f, 0.f, 0.f, 0.f};
#pragma unroll
                for (int kb = 0; kb < 2; ++kb) { f32x4 x[8];
#pragma unroll
                    for (int k4 = 0; k4 < 4; ++k4) { x[2 * k4] = *(const f32x4*)(cp + 32 * (4 * kb + k4)); x[2 * k4 + 1] = *(const f32x4*)(cp + 32 * (4 * kb + k4) + 4); }
#pragma unroll
                    for (int k4 = 0; k4 < 4; ++k4) { const int ks = 4 * kb + k4; const bf16x8 af = cvt8(x[2 * k4], x[2 * k4 + 1]);
                        *(bf16x8*)(tile + hf * 16 * TPITCH + wr_off + 64 * ks) = af;
                        acc = __builtin_amdgcn_mfma_f32_16x16x32_bf16(af, qa[ks], acc, 0, 0, 0); }
                    asm volatile("" ::: "memory"); }
                acc = __builtin_amdgcn_mfma_f32_16x16x32_bf16(cvt8(r0, r1), qrp, acc, 0, 0, 0);
                s[hf] = acc * C; asm volatile("" ::: "memory"); }
            float mx = fmaxf(fmaxf(fmaxf(s[0][0], s[0][1]), fmaxf(s[0][2], s[0][3])), fmaxf(fmaxf(s[1][0], s[1][1]), fmaxf(s[1][2], s[1][3])));
            mx = fmaxf(mx, __shfl_xor(mx, 16)); mx = fmaxf(mx, __shfl_xor(mx, 32));
            const float mn = fmaxf(m, mx), alpha = __builtin_amdgcn_exp2f(m - mn); m = mn;
            f32x4 p0, p1; float ps = 0.f;
#pragma unroll
            for (int i = 0; i < 4; ++i) { p0[i] = __builtin_amdgcn_exp2f(s[0][i] - mn); p1[i] = __builtin_amdgcn_exp2f(s[1][i] - mn); ps += p0[i] + p1[i]; }
            ps += __shfl_xor(ps, 16); ps += __shfl_xor(ps, 32);
            l = l * alpha + ps;
            const bf16x8 pf = cvt8(p0, p1);
            asm volatile("s_waitcnt lgkmcnt(0)" ::: "memory");
#define SA_RD(CB, LO, HI) const s16x4 LO = att::tr_read<(CB) * 32>(rd_lo), HI = att::tr_read<(CB) * 32 + 16 * TPITCH>(rd_lo)
#define SA_MM(CB, LO, HI) do { const bf16x8 af = (bf16x8){LO[0], LO[1], LO[2], LO[3], HI[0], HI[1], HI[2], HI[3]}; \
                o[CB] = o[CB] * alpha; o[CB] = __builtin_amdgcn_mfma_f32_16x16x32_bf16(af, pf, o[CB], 0, 0, 0); } while (0)
#define SA_PV4(B) do { SA_RD(B, l0, h0); SA_RD(B + 1, l1, h1); SA_RD(B + 2, l2, h2); SA_RD(B + 3, l3, h3); \
                asm volatile("s_waitcnt lgkmcnt(0)" ::: "memory"); __builtin_amdgcn_sched_barrier(0); \
                SA_MM(B, l0, h0); SA_MM(B + 1, l1, h1); SA_MM(B + 2, l2, h2); SA_MM(B + 3, l3, h3); } while (0)
            SA_PV4(0); SA_PV4(4); SA_PV4(8); SA_PV4(12);
#undef SA_RD
#undef SA_MM
#undef SA_PV4
            asm volatile("s_waitcnt lgkmcnt(0)" ::: "memory");
        }
    }
    int zo = 0; asm volatile("" : "+v"(zo));
    float* of = (float*)(tile + zo);
    if (l16 < 8) {
#pragma unroll
        for (int cb = 0; cb < 16; ++cb)
#pragma unroll
            for (int i = 0; i < 4; ++i) of[l16 * 256 + 16 * cb + 4 * g + i] = o[cb][i];
        if (g == 0) { of[2048 + l16] = m; of[2056 + l16] = l; }
    }
    __syncthreads();
    float* part = PART + (size_t)un * PART_STRIDE + zo; const char* ldz = lds + zo;
#pragma unroll
    for (int k = 0; k < 4; ++k) { const int e = tid + 512 * k, h = e >> 8;
        float M = -1e30f;
#pragma unroll
        for (int w = 0; w < 8; ++w) M = fmaxf(M, ((const float*)(ldz + w * TILE_BYTES))[2048 + h]);
        float v = 0.f, L = 0.f;
#pragma unroll
        for (int w = 0; w < 8; ++w) { const float* ow = (const float*)(ldz + w * TILE_BYTES); const float sc = __builtin_amdgcn_exp2f(ow[2048 + h] - M); v += sc * ow[e]; L += sc * ow[2056 + h]; }
        part[e] = v;
        if ((e & 255) == 0) { part[2048 + h] = M; part[2056 + h] = L; } }
    __syncthreads();
}
__device__ __forceinline__ void combine_unit(int bs, const float* __restrict__ PART, const bf16_t* __restrict__ QB, const bf16_t* __restrict__ QABS, const float* __restrict__ ckv_s, const float* __restrict__ kr_s,
                                             const float* __restrict__ w_uv, bf16_t* __restrict__ AB, float* __restrict__ rsqa, LAS float* ol  ) {
    int tid_ = threadIdx.x; asm volatile("" : "+v"(tid_)); const int tid = tid_, h = tid >> 6, lane = tid & 63;
    constexpr float C = ATT_SCALE * LOG2E;
    const float* cn = ckv_s + (size_t)bs * KVL; const bf16_t* qa = QABS + (size_t)(bs * 8 + h) * 256;
    float s = 0.f;
#pragma unroll
    for (int i = 0; i < 4; ++i) s += bf2f(qa[lane * 4 + i]) * cn[lane * 4 + i];
    if (lane < 32) s += bf2f(QB[(size_t)(MP + bs) * 768 + h * 96 + 64 + lane]) * kr_s[(size_t)bs * RD + lane];
    s = wave_sum(s) * C;
    float M = s;
#pragma unroll
    for (int j = 0; j < NSPLIT; ++j) M = fmaxf(M, PART[(size_t)(bs * NSPLIT + j) * PART_STRIDE + 2048 + h]);
    const float en = __builtin_amdgcn_exp2f(s - M); float L = en; float ej[NSPLIT];
#pragma unroll
    for (int j = 0; j < NSPLIT; ++j) { const float* p = PART + (size_t)(bs * NSPLIT + j) * PART_STRIDE; ej[j] = __builtin_amdgcn_exp2f(p[2048 + h] - M); L += ej[j] * p[2056 + h]; }
    const float il = 1.f / L;
#pragma unroll
    for (int i = 0; i < 4; ++i) { const int c = lane * 4 + i; float v = en * cn[c];
#pragma unroll
        for (int j = 0; j < NSPLIT; ++j) v += ej[j] * PART[(size_t)(bs * NSPLIT + j) * PART_STRIDE + h * 256 + c];
        ol[h * 256 + c] = v * il; }
    __syncthreads();
    float a = 0.f;
    for (int c = 0; c < KVL; ++c) a = fmaf(ol[h * 256 + c], w_uv[(size_t)c * 512 + h * 64 + lane], a);
    const unsigned short ab = (unsigned short)(cvt_pk_bf16(a, a) & 0xffffu);
    AB[(size_t)(MP + bs) * DM + h * 64 + lane] = ab;
    const float ar = bf2f(ab); const float ss = wave_sum(ar * ar);
    if (lane == 0) unsafeAtomicAdd(rsqa + MP + bs, ss);
    __syncthreads();
}
}
namespace fk {
using namespace fx;
constexpr int NWAVES = 8, NPHASE = 13;
constexpr size_t al(size_t x) { return (x + 255) / 256 * 256; }
constexpr size_t CTL_ZERO_BYTES = 1u << 20;
constexpr int CW_BAR = 4096;
constexpr size_t RSQ_OFF = 65536, RSQ_STRIDE = (size_t)MPAD * 4;
static_assert(RSQ_OFF + 8 * RSQ_STRIDE <= CTL_ZERO_BYTES, "ctl");
constexpr size_t O_W1GU = CTL_ZERO_BYTES, O_W1D = O_W1GU + al((size_t)2 * FF * DM * 2), O_WIN = O_W1D + al((size_t)DM * FF * 2), O_WUQ = O_WIN + al((size_t)2816 * DM * 2),
    O_WUKV = O_WUQ + al((size_t)768 * QL * 2), O_WOUT = O_WUKV + al((size_t)1024 * KVL * 2), O_W2GU = O_WOUT + al((size_t)DM * DM * 2), O_W2D = O_W2GU + al((size_t)2 * FF * DM * 2),
    O_WPG = O_W2D + al((size_t)DM * FF * 2), O_WPP = O_WPG + al((size_t)DM * DM * 2), O_AB0 = O_WPP + al((size_t)DM * PLE * 2), O_AB1 = O_AB0 + al((size_t)MPAD * DM * 2),
    O_ACT = O_AB1 + al((size_t)MPAD * DM * 2), O_H = O_ACT + al((size_t)MPAD * FF * 2), O_PEB = O_H + al((size_t)MPAD * DM * 4), O_PROJ = O_PEB + al((size_t)MPAD * PLE * 2),
    O_ZKV = O_PROJ + al((size_t)MPAD * DM * 2), O_ZQ = O_ZKV + al((size_t)MPAD * KVL * 2), O_MQ = O_ZQ + al((size_t)MPAD * QL * 2), O_MK = O_MQ + al((size_t)MPAD * 512 * 2),
    O_MV = O_MK + al((size_t)MPAD * 512 * 2), O_MO = O_MV + al((size_t)MPAD * 512 * 2), O_GATES = O_MO + al((size_t)MPAD * 512 * 2), O_QB = O_GATES + al((size_t)MPAD * 8 * 4),
    O_KB = O_QB + al((size_t)MPAD * 768 * 2), O_VB = O_KB + al((size_t)MPAD * 768 * 2), O_DCT = O_VB + al((size_t)MPAD * 512 * 2), O_DN = O_DCT + al((size_t)ml::NUNIT * 16384 * 4),
    O_ALAST = O_DN + al((size_t)ml::NUNIT * 128 * 4), O_BL = O_ALAST + al((size_t)ml::NUNIT * 4), O_CT = O_BL + al((size_t)ml::NUNIT * 4), O_NST = O_CT + al((size_t)ml::NUNIT * 16384 * 2),
    O_MST = O_NST + al((size_t)ml::NUNIT * 128 * 4), O_QABS = O_MST + al((size_t)ml::NUNIT * 4), O_PART = O_QABS + al((size_t)MS * 8 * 256 * 2),
    O_ROPE = O_PART + al((size_t)sa::NUNIT * sa::PART_STRIDE * 4), WS_FAST_END = O_ROPE + al((size_t)ROPE_NPOS * 32 * 4);
constexpr int RING_BYTES = 8 * sa::TILE_BYTES;
static_assert(RING_BYTES >= pg8::STAGE_BYTES && RING_BYTES >= att::LDS_BYTES, "ring");
constexpr int SMALL_OFF = RING_BYTES, MISC_OFF = SMALL_OFF + 2 * 8192, LDS_BYTES = MISC_OFF + 256;
static_assert(LDS_BYTES <= 163840, "LDS");
static_assert(O_MV - O_MK == O_MK - O_MQ && O_MO - O_MV == O_MK - O_MQ, "MQ|MK|MV|MO stride");

#define RLX_AGENT __ATOMIC_RELAXED, __HIP_MEMORY_SCOPE_AGENT
#define LDS_WAIT() asm volatile("s_waitcnt lgkmcnt(0)" ::: "memory")
#define XB_TMO      128
#define XB_XCNT(j)  (256  + 64 * (j))
#define XB_XSUB(j)  (1280 + 64 * (j))
#define XB_XGEN(j)  (2304 + 64 * (j))
#define XB_TOP      3328
#define XB_TOPGEN   3392
#define XCD_BAR_WORDS 3456
#define XB_SPIN_CAP (1u << 18)
__device__ __forceinline__ unsigned xb_ld(unsigned* p)              { return __hip_atomic_load(p, __ATOMIC_RELAXED, __HIP_MEMORY_SCOPE_AGENT); }
__device__ __forceinline__ unsigned xb_add(unsigned* p, unsigned v) { return __hip_atomic_fetch_add(p, v, __ATOMIC_RELAXED, __HIP_MEMORY_SCOPE_AGENT); }
__device__ __forceinline__ unsigned xb_xcc_id() { return (unsigned)__builtin_amdgcn_s_getreg((3 << 11) | 20) & 0xFu; }
#define XB_SPIN(cond, bar) do { unsigned _sp = 0; while (cond) { __builtin_amdgcn_s_sleep(1); \
    if ((++_sp & 255u) == 0u) { if (xb_ld(&(bar)[XB_TMO])) break; if (_sp > XB_SPIN_CAP) { atomicAdd(&(bar)[XB_TMO], 1u); break; } } } } while (0)
struct XcdBarrier { unsigned* bar; unsigned x; volatile LAS unsigned* st; };
__device__ __forceinline__ XcdBarrier xcd_barrier_post(unsigned* bar, volatile LAS unsigned* st) {
    XcdBarrier b; b.bar = bar; b.x = xb_xcc_id(); b.st = st;
    if (threadIdx.x == 0) (void)xb_add(&bar[XB_XCNT(b.x)], 1u);
    return b;
}
__device__ __forceinline__ void xcd_barrier_complete(unsigned* bar, unsigned x, unsigned& nloc, unsigned& nx) {
    const unsigned G = gridDim.x * gridDim.y * gridDim.z;
    unsigned sum, cnt, mine, sp = 0u;
    for (;;) {
        sum = 0u; cnt = 0u; mine = 0u;
#pragma unroll
        for (unsigned j = 0; j < 16; ++j) { const unsigned c = xb_ld(&bar[XB_XCNT(j)]); sum += c; cnt += (c > 0u) ? 1u : 0u; mine = (j == x) ? c : mine; }
        if (sum == G) break;
        __builtin_amdgcn_s_sleep(1);
        if ((++sp & 255u) == 0u) { if (xb_ld(&bar[XB_TMO])) break; if (sp > XB_SPIN_CAP) { atomicAdd(&bar[XB_TMO], 1u); break; } }
    }
    nloc = mine > 0u ? mine : 1u; nx = cnt > 0u ? cnt : 1u;
}
__device__ __forceinline__ void xcd_barrier(const XcdBarrier& b) {
    asm volatile("s_waitcnt vmcnt(0)" ::: "memory");
    __syncthreads();
    if (threadIdx.x == 0) {
        unsigned* bar = b.bar;
        __builtin_amdgcn_s_waitcnt(0);
        unsigned nloc = b.st[0], nx = b.st[1];
        if (nloc == 0u) { xcd_barrier_complete(bar, b.x, nloc, nx); b.st[0] = nloc; b.st[1] = nx; }
        const unsigned old = xb_add(&bar[XB_XSUB(b.x)], 1u);
        const unsigned gen = old / nloc;
        if (old + 1u == (gen + 1u) * nloc) {
            __builtin_amdgcn_fence(__ATOMIC_RELEASE, "agent");
            asm volatile("s_waitcnt vmcnt(0)" ::: "memory");
            const unsigned og = xb_add(&bar[XB_TOP], 1u);
            const unsigned tg = og / nx;
            if (og + 1u == (tg + 1u) * nx) xb_add(&bar[XB_TOPGEN], 1u);
            else XB_SPIN(xb_ld(&bar[XB_TOPGEN]) == tg, bar);
            __builtin_amdgcn_fence(__ATOMIC_ACQUIRE, "agent");
            xb_add(&bar[XB_XGEN(b.x)], 1u);
            asm volatile("s_waitcnt vmcnt(0)" ::: "memory");
        } else {
            XB_SPIN(xb_ld(&bar[XB_XGEN(b.x)]) == gen, bar);
            __builtin_amdgcn_fence(__ATOMIC_ACQUIRE, "agent");
            asm volatile("s_waitcnt vmcnt(0)" ::: "memory");
        }
    }
    __syncthreads();
}
struct Out { float *y_p, *y_s, *ckv_p, *kr_p, *C_p, *n_p, *m_p, *ckv_s, *kr_s, *C_s, *n_s, *m_s; };
__host__ __device__ __forceinline__ Out carve_out(float* o) {
    Out r; size_t off = 0;
    r.y_p = o + off; off += (size_t)MP * DM; r.y_s = o + off; off += (size_t)MS * DM;
    r.ckv_p = o + off; off += (size_t)MP * KVL; r.kr_p = o + off; off += (size_t)MP * RD;
    r.C_p = o + off; off += (size_t)NB * MH * MD * MD; r.n_p = o + off; off += (size_t)NB * MH * MD; r.m_p = o + off; off += NB * MH;
    r.ckv_s = o + off; off += (size_t)MS * KVL; r.kr_s = o + off; off += (size_t)MS * RD;
    r.C_s = o + off; off += (size_t)MS * MH * MD * MD; r.n_s = o + off; off += (size_t)MS * MH * MD; r.m_s = o + off; off += MS * MH;
    return r;
}
constexpr size_t OUT_FLOATS = (size_t)MP * DM + (size_t)MS * DM + (size_t)MP * KVL + (size_t)MP * RD + (size_t)NB * MH * MD * MD + (size_t)NB * MH * MD + NB * MH
                            + (size_t)MS * KVL + (size_t)MS * RD + (size_t)MS * MH * MD * MD + (size_t)MS * MH * MD + MS * MH;
struct Src { const float* base; int ld; int col; float scale; };
template <class CM, class GN> __device__ __forceinline__ void tr_item(CM colmap, GN gain, int K, int nblk, bf16_t* WT, LAS float* scr, int item, int lane) {
    const int kb = item / nblk, nb = item % nblk, k0 = 64 * kb, n0 = 32 * nb;
    const Src s = colmap(n0 + (lane & 31));
#pragma unroll 8
    for (int i = 0; i < 32; ++i) { const int kk = 2 * i + (lane >> 5); scr[kk * 33 + (lane & 31)] = s.base ? s.base[(size_t)(k0 + kk) * s.ld + s.col] * gain(k0 + kk) * s.scale : 0.f; }
    LDS_WAIT(); asm volatile("" ::: "memory");
    const int c = lane & 7;
#pragma unroll
    for (int j = 0; j < 4; ++j) { const int n = (lane >> 3) + 8 * j; const LAS float* p = scr + (8 * c) * 33 + n;
        u32x4 o; o.x = cvt_pk_bf16(p[0 * 33], p[1 * 33]); o.y = cvt_pk_bf16(p[2 * 33], p[3 * 33]); o.z = cvt_pk_bf16(p[4 * 33], p[5 * 33]); o.w = cvt_pk_bf16(p[6 * 33], p[7 * 33]);
        *(u32x4*)(WT + (size_t)(n0 + n) * K + k0 + 8 * c) = o; }
    LDS_WAIT(); asm volatile("" ::: "memory");
}
struct Args { const void* in[34]; float* out; unsigned char* ws; int ph_lo, ph_hi, use_bar, pad; };

__global__ void __launch_bounds__(NWAVES * 64, 2) fwd(Args args) {
    extern __shared__ __attribute__((aligned(16))) unsigned char lds[];
    LAS unsigned char* L = (LAS unsigned char*)lds;
    const int tid = threadIdx.x, lane = tid & 63, wave = __builtin_amdgcn_readfirstlane(tid >> 6);
    const int G = gridDim.x, bx = blockIdx.x, vcu = (G % 8 == 0) ? (bx % 8) * (G / 8) + bx / 8 : bx;
    unsigned char* ws = args.ws;
    unsigned* ctl = (unsigned*)ws;
    for (int u = tid; u < (LDS_BYTES - SMALL_OFF) / 4; u += NWAVES * 64) ((LAS unsigned*)(L + SMALL_OFF))[u] = 0u;
    __syncthreads();
    XcdBarrier bar; bar.bar = ctl + CW_BAR; bar.x = 0; bar.st = nullptr;
    if (args.use_bar) bar = xcd_barrier_post(ctl + CW_BAR, (volatile LAS unsigned*)(L + MISC_OFF));
    const int lo = args.ph_lo, hi = args.ph_hi;
#ifndef SUB4
#define SUB4 0xff
#endif
#ifndef SUB6
#define SUB6 0xff
#endif
#ifndef PHASE_MASK
#define PHASE_MASK 0xffff
#endif
#define IN(k) (((PHASE_MASK >> (k)) & 1) && lo <= (k) && (k) < hi)
#define SEAM(k) do { if (IN(k) && IN((k) + 1)) xcd_barrier(bar); } while (0)
#define LDF(name, idx) const float* name = (const float*)args.in[idx]
    const Out O = carve_out(args.out);
#define P_rsq0 ((float*)(ws + RSQ_OFF))
#define P_rsq1 (P_rsq0 + MPAD)
#define P_rsqkv (P_rsq1 + MPAD)
#define P_rsqq (P_rsqkv + MPAD)
#define P_rsqa (P_rsqq + MPAD)
#define P_rsq2 (P_rsqa + MPAD)
#define P_rsq3 (P_rsq2 + MPAD)
#define P_rsq4 (P_rsq3 + MPAD)
#define P_W1GU ((bf16_t*)(ws + O_W1GU))
#define P_W1D ((bf16_t*)(ws + O_W1D))
#define P_WIN ((bf16_t*)(ws + O_WIN))
#define P_WUQ ((bf16_t*)(ws + O_WUQ))
#define P_WUKV ((bf16_t*)(ws + O_WUKV))
#define P_WOUT ((bf16_t*)(ws + O_WOUT))
#define P_W2GU ((bf16_t*)(ws + O_W2GU))
#define P_W2D ((bf16_t*)(ws + O_W2D))
#define P_WPG ((bf16_t*)(ws + O_WPG))
#define P_WPP ((bf16_t*)(ws + O_WPP))
#define P_AB0 ((bf16_t*)(ws + O_AB0))
#define P_AB1 ((bf16_t*)(ws + O_AB1))
#define P_ACT ((bf16_t*)(ws + O_ACT))
#define P_H ((float*)(ws + O_H))
#define P_PEB ((bf16_t*)(ws + O_PEB))
#define P_PROJ ((bf16_t*)(ws + O_PROJ))
#define P_ZKV ((bf16_t*)(ws + O_ZKV))
#define P_ZQ ((bf16_t*)(ws + O_ZQ))
#define P_MQ ((bf16_t*)(ws + O_MQ))
#define P_MK ((bf16_t*)(ws + O_MK))
#define P_MV ((bf16_t*)(ws + O_MV))
#define P_MO ((bf16_t*)(ws + O_MO))
#define P_GATES ((float*)(ws + O_GATES))
#define P_QB ((bf16_t*)(ws + O_QB))
#define P_KB ((bf16_t*)(ws + O_KB))
#define P_VB ((bf16_t*)(ws + O_VB))
#define P_DCT ((float*)(ws + O_DCT))
#define P_DN ((float*)(ws + O_DN))
#define P_ALAST ((float*)(ws + O_ALAST))
#define P_BL ((float*)(ws + O_BL))
#define P_CT ((bf16_t*)(ws + O_CT))
#define P_NST ((float*)(ws + O_NST))
#define P_MST ((float*)(ws + O_MST))
#define P_QABS ((bf16_t*)(ws + O_QABS))
#define P_PART ((float*)(ws + O_PART))
#define P_ROPE ((float*)(ws + O_ROPE))
    LAS ml::Small* smalls = (LAS ml::Small*)(L + SMALL_OFF);
    const int gw = vcu * NWAVES + wave, NGW = G * NWAVES;

    if (IN(0)) {
        int lane_ = threadIdx.x & 63; asm volatile("" : "+v"(lane_)); const int lane = lane_;
        LDF(x_p, 0); LDF(x_s, 1); LDF(p_p, 2); LDF(p_s, 3); LDF(g_ff1, 10); LDF(w1g, 11); LDF(w1u, 12); LDF(w1d, 13); LDF(g_mix, 14); LDF(w_in, 15); LDF(g_q, 16); LDF(w_uq, 17); LDF(g_kv, 18); LDF(w_uk, 19); LDF(w_uv, 20);
        LDF(g_ao, 23); LDF(g_mo, 24); LDF(w_out, 25); LDF(g_ff2, 26); LDF(w2g, 27); LDF(w2u, 28); LDF(w2d, 29); LDF(g_ple, 30); LDF(w_pg, 31); LDF(w_pp, 32);
        LAS float* scr = (LAS float*)(L + wave * 16384);
        constexpr int I_GU = (DM / 64) * (2 * FF / 32), I_D = (FF / 64) * (DM / 32), I_IN = (DM / 64) * (2816 / 32), I_UQ = (QL / 64) * (768 / 32), I_UKV = (KVL / 64) * (1024 / 32),
                      I_OUT = (DM / 64) * (DM / 32), I_PG = I_OUT, I_PP = (PLE / 64) * (DM / 32);
        constexpr int NITEMS = 2 * I_GU + 2 * I_D + I_IN + I_UQ + I_UKV + I_OUT + I_PG + I_PP;
        auto one = [](int) { return 1.f; };
        for (int it = gw; it < NITEMS; it += NGW) {
            int r = it;
            if (r < 2 * I_GU) { const bool second = r >= I_GU; if (second) r -= I_GU; const float* wg = second ? w2g : w1g; const float* wu = second ? w2u : w1u; const float* gg = second ? g_ff2 : g_ff1;
                tr_item([=](int n) { const int pn = n >> 8, q = n & 255; return (q < 128) ? Src{wg, FF, 128 * pn + q, 1.f} : Src{wu, FF, 128 * pn + q - 128, 1.f}; }, [=](int k) { return gg[k]; }, DM, 2 * FF / 32, second ? P_W2GU : P_W1GU, scr, r, lane); continue; }
            r -= 2 * I_GU;
            if (r < 2 * I_D) { const bool second = r >= I_D; if (second) r -= I_D; const float* wd = second ? w2d : w1d;
                tr_item([=](int n) { return Src{wd, DM, n, 1.f}; }, one, FF, DM / 32, second ? P_W2D : P_W1D, scr, r, lane); continue; }
            r -= 2 * I_D;
            if (r < I_IN) { tr_item([=](int n) { if (n < 256) return Src{w_in, 2728, 384 + n, 1.f}; if (n < 640) return Src{w_in, 2728, n - 256, 1.f};
                    if (n < 672) { const int j = n - 640; return Src{w_in, 2728, 640 + (j >> 1) + 16 * (j & 1), 1.f}; }
                    if (n < 676) return Src{w_in, 2728, 2720 + (n - 672), 1.f}; if (n < 680) return Src{w_in, 2728, 2724 + (n - 676), 1.f};
                    if (n < 768) return Src{nullptr, 0, 0, 0.f};
                    if (n < 1280) return Src{w_in, 2728, 672 + (n - 768), 1.f}; if (n < 1792) return Src{w_in, 2728, 1184 + (n - 1280), 0.08838834764831845f};
                    if (n < 2304) return Src{w_in, 2728, 1696 + (n - 1792), 1.f}; return Src{w_in, 2728, 2208 + (n - 2304), 1.f}; },
                    [=](int k) { return g_mix[k]; }, DM, 2816 / 32, P_WIN, scr, r, lane); continue; }
            r -= I_IN;
            if (r < I_UQ) { tr_item([=](int n) { const int h = n / 96, d = n - h * 96; if (d < 64) return Src{w_uq, 768, n, 1.f}; const int j = d - 64; return Src{w_uq, 768, h * 96 + 64 + (j >> 1) + 16 * (j & 1), 1.f}; },
                    [=](int k) { return g_q[k]; }, QL, 768 / 32, P_WUQ, scr, r, lane); continue; }
            r -= I_UQ;
            if (r < I_UKV) { tr_item([=](int n) { return n < 512 ? Src{w_uk, 512, n, 1.f} : Src{w_uv, 512, n - 512, 1.f}; }, [=](int k) { return g_kv[k]; }, KVL, 1024 / 32, P_WUKV, scr, r, lane); continue; }
            r -= I_UKV;
            if (r < I_OUT) { tr_item([=](int n) { return Src{w_out, DM, n, 1.f}; }, [=](int k) { return k < 512 ? g_ao[k] : g_mo[k - 512]; }, DM, DM / 32, P_WOUT, scr, r, lane); continue; }
            r -= I_OUT;
            if (r < I_PG) { tr_item([=](int n) { return Src{w_pg, DM, n, 1.f}; }, [=](int k) { return g_ple[k]; }, DM, DM / 32, P_WPG, scr, r, lane); continue; }
            r -= I_PG;
            tr_item([=](int n) { return Src{w_pp, DM, n, 1.f}; }, one, PLE, DM / 32, P_WPP, scr, r, lane);
        }
        for (int e = gw * 64 + lane; e < ROPE_NPOS * 16; e += NGW * 64) { float cs, sn; rope_cs(e >> 4, e & 15, cs, sn); P_ROPE[(size_t)(e >> 4) * 32 + (e & 15)] = cs; P_ROPE[(size_t)(e >> 4) * 32 + 16 + (e & 15)] = sn; }
        for (int row = gw; row < MPAD; row += NGW) {
            GAS u32x2* o8 = (GAS u32x2*)(P_AB0 + (size_t)row * DM) + lane;
            if (row < MT) { const float* xr = row < MP ? x_p + (size_t)row * DM : x_s + (size_t)(row - MP) * DM; const float* pr = row < MP ? p_p + (size_t)row * PLE : p_s + (size_t)(row - MP) * PLE;
                float s = 0.f;
#pragma unroll
                for (int j = 0; j < 4; ++j) { const f32x4 v = *((const f32x4*)xr + lane + 64 * j); s += (v.x * v.x + v.y * v.y) + (v.z * v.z + v.w * v.w); u32x2 w; w.x = cvt_pk_bf16(v.x, v.y); w.y = cvt_pk_bf16(v.z, v.w); o8[64 * j] = w; }
                s = wave_sum(s); if (lane == 0) P_rsq0[row] = s;
                const f32x4 pv = *((const f32x4*)pr + lane); u32x2 w; w.x = cvt_pk_bf16(pv.x, pv.y); w.y = cvt_pk_bf16(pv.z, pv.w); *((GAS u32x2*)(P_PEB + (size_t)row * PLE) + lane) = w;
            } else { const u32x2 z = {0u, 0u};
#pragma unroll
                for (int j = 0; j < 4; ++j) o8[64 * j] = z;
                *((GAS u32x2*)(P_PEB + (size_t)row * PLE) + lane) = z; }
        }
    }
    SEAM(0);
    if (IN(1)) { pg8::Gemm g{P_AB0, P_W1GU, MPAD, 2 * FF, DM, DM, DM}; pg8::StaticOrder So; So.init(MPAD, 2 * FF, G, bx); pg8::EpiSwiGLU E; E.act = P_ACT; E.rsq = P_rsq0;
        pg8::gemm_phase<pg8::EpiSwiGLU, pg8::StaticOrder, true, true>(L, g, So, E); }
    SEAM(1);
    if (IN(2)) { LDF(x_p, 0); LDF(x_s, 1); pg8::Gemm g{P_ACT, P_W1D, MPAD, DM, FF, FF, FF}; pg8::StaticOrder So; So.init(MPAD, DM, G, bx); pg8::EpiResid<0> E; E.xp = x_p; E.xs = x_s; E.H = P_H; E.AB = P_AB1; E.rsq = P_rsq1; E.rsqa = nullptr;
        pg8::gemm_phase<pg8::EpiResid<0>, pg8::StaticOrder, true, true>(L, g, So, E); }
    SEAM(2);
    if (IN(3)) { pg8::Gemm g{P_AB1, P_WIN, MPAD, 2816, DM, DM, DM}; pg8::StaticOrder So; So.init(MPAD, 2816, G, bx);
        pg8::EpiZ E; E.rsq1 = P_rsq1; E.ROPE = P_ROPE; E.ZKV = P_ZKV; E.ZQ = P_ZQ; E.KB = P_KB; E.MQ = P_MQ; E.mstride = (O_MK - O_MQ) / 2; E.GATES = P_GATES; E.ckv_p = O.ckv_p; E.ckv_s = O.ckv_s; E.kr_p = O.kr_p; E.kr_s = O.kr_s; E.rsqkv = P_rsqkv; E.rsqq = P_rsqq;
        pg8::gemm_phase<pg8::EpiZ, pg8::StaticOrder, true, true>(L, g, So, E); }
    SEAM(3);
    if (IN(4)) {
        LDF(sC, 6); LDF(sn, 7); LDF(smst, 8); LDF(g_kv, 18); LDF(b_i, 21); LDF(b_f, 22);
        if (SUB4 & 1) { pg8::Gemm g{P_ZQ, P_WUQ, MPAD, 768, QL, QL, QL}; pg8::StaticOrder So; So.init(MPAD, 768, G, bx); pg8::EpiQ E; E.rsqq = P_rsqq; E.ROPE = P_ROPE; E.QB = P_QB;
          pg8::gemm_phase<pg8::EpiQ, pg8::StaticOrder, true, true>(L, g, So, E); }
        if (SUB4 & 2) { pg8::Gemm g{P_ZKV, P_WUKV, MPAD, 1024, KVL, KVL, KVL}; pg8::StaticOrder So; So.init(MPAD, 1024, G, bx); pg8::EpiKV E; E.rsqkv = P_rsqkv; E.KB = P_KB; E.VB = P_VB; E.ckv_p = O.ckv_p; E.ckv_s = O.ckv_s; E.g_kv = g_kv;
          pg8::gemm_phase<pg8::EpiKV, pg8::StaticOrder, true, true>(L, g, So, E); }
        if (SUB4 & 4) { pg8::Gemm g{P_PEB, P_WPP, MPAD, DM, PLE, PLE, PLE}; pg8::StaticOrder So; So.init(MPAD, DM, G, bx); pg8::EpiPlain E; E.O = P_PROJ; E.ldo = DM;
          pg8::gemm_phase<pg8::EpiPlain, pg8::StaticOrder, true, true>(L, g, So, E); }
        if (SUB4 & 8) for (int pr = vcu; pr < ml::NUNIT / 2; pr += G) ml::local_pair(pr, P_MK, P_MV, P_GATES, b_i, b_f, P_DCT, P_DN, P_ALAST, P_BL, (char*)lds, smalls);
        if (SUB4 & 16) for (int u = vcu; u < MS * MH; u += G) ml::sample_step(u, P_MQ, P_MK, P_MV, P_MO, P_GATES, b_i, b_f, sC, sn, smst, O.C_s, O.n_s, O.m_s, P_AB0, (LAS float*)L);
    }
    SEAM(4);
    if (IN(5)) {
        LDF(w_uk, 19);
        ml::scan_all(vcu, G, P_DCT, P_DN, P_ALAST, P_BL, P_CT, P_NST, P_MST, O.C_p, O.n_p, O.m_p);
        for (int bs = vcu; bs < MS; bs += G) sa::qabs_unit(bs, P_QB, w_uk, P_QABS, (LAS float*)L);
    }
    SEAM(5);
    if (IN(6)) {
        LDF(cache_c, 4); LDF(cache_r, 5); const int* pt = (const int*)args.in[9]; LDF(b_i, 21); LDF(b_f, 22);
        const bool sample_first = (vcu & 1) != 0;
        if ((SUB6 & 1) && sample_first) for (int un = vcu; un < sa::NUNIT; un += G) sa::part_unit(un, P_QB, P_QABS, cache_c, cache_r, pt, P_PART, (char*)lds);
        if (SUB6 & 2) for (int p = vcu; p < 256; p += G) { const int bh = p >> 4, s = p & 15;
            att::attn_unit(bh >> 3, bh & 7, s, P_QB, P_KB, P_VB, P_AB0, P_rsqa, (char*)lds); att::attn_unit(bh >> 3, bh & 7, 31 - s, P_QB, P_KB, P_VB, P_AB0, P_rsqa, (char*)lds); }
        if (SUB6 & 4) for (int pr = vcu; pr < ml::NUNIT / 2; pr += G) ml::out_pair(pr, P_MQ, P_MK, P_MV, P_MO, P_GATES, b_i, b_f, P_CT, P_NST, P_MST, P_AB0, (char*)lds, smalls);
        if ((SUB6 & 1) && !sample_first) for (int un = vcu; un < sa::NUNIT; un += G) sa::part_unit(un, P_QB, P_QABS, cache_c, cache_r, pt, P_PART, (char*)lds);
    }
    SEAM(6);
    if (IN(7)) { LDF(w_uv, 20); for (int bs = vcu; bs < MS; bs += G) sa::combine_unit(bs, P_PART, P_QB, P_QABS, O.ckv_s, O.kr_s, w_uv, P_AB0, P_rsqa, (LAS float*)L); }
    SEAM(7);
    if (IN(8)) { pg8::Gemm g{P_AB0, P_WOUT, MPAD, DM, DM, DM, DM}; pg8::StaticOrder So; So.init(MPAD, DM, G, bx); pg8::EpiResid<1> E; E.xp = nullptr; E.xs = nullptr; E.H = P_H; E.AB = P_AB1; E.rsq = P_rsq2; E.rsqa = P_rsqa;
        pg8::gemm_phase<pg8::EpiResid<1>, pg8::StaticOrder, true, true>(L, g, So, E); }
    SEAM(8);
    if (IN(9)) { pg8::Gemm g{P_AB1, P_W2GU, MPAD, 2 * FF, DM, DM, DM}; pg8::StaticOrder So; So.init(MPAD, 2 * FF, G, bx); pg8::EpiSwiGLU E; E.act = P_ACT; E.rsq = P_rsq2;
        pg8::gemm_phase<pg8::EpiSwiGLU, pg8::StaticOrder, true, true>(L, g, So, E); }
    SEAM(9);
    if (IN(10)) { pg8::Gemm g{P_ACT, P_W2D, MPAD, DM, FF, FF, FF}; pg8::StaticOrder So; So.init(MPAD, DM, G, bx); pg8::EpiResid<2> E; E.xp = nullptr; E.xs = nullptr; E.H = P_H; E.AB = P_AB0; E.rsq = P_rsq3; E.rsqa = nullptr;
        pg8::gemm_phase<pg8::EpiResid<2>, pg8::StaticOrder, true, true>(L, g, So, E); }
    SEAM(10);
    if (IN(11)) { pg8::Gemm g{P_AB0, P_WPG, MPAD, DM, DM, DM, DM}; pg8::StaticOrder So; So.init(MPAD, DM, G, bx); pg8::EpiPle E; E.rsq3 = P_rsq3; E.PROJ = P_PROJ; E.H = P_H; E.y_p = O.y_p; E.y_s = O.y_s; E.rsq4 = P_rsq4;
        pg8::gemm_phase<pg8::EpiPle, pg8::StaticOrder, true, true>(L, g, So, E); }
    SEAM(11);
    if (IN(12)) {
        int lane_ = threadIdx.x & 63; asm volatile("" : "+v"(lane_)); const int lane = lane_;
        LDF(g_fin, 33);
        for (int row = gw; row < MT; row += NGW) { float* yr = row < MP ? O.y_p + (size_t)row * DM : O.y_s + (size_t)(row - MP) * DM; const float rs = rstd_of(P_rsq4, row, 1.f / DM);
#pragma unroll
            for (int j = 0; j < 4; ++j) { f32x4 v = *((f32x4*)yr + lane + 64 * j); const f32x4 gv = *((const f32x4*)g_fin + lane + 64 * j); v = v * gv * rs; *((f32x4*)yr + lane + 64 * j) = v; } }
    }
#undef IN
#undef SEAM
}
}
#ifndef DBG
#define DBG 0
#endif
#ifndef DBG_REPORT
#define DBG_REPORT -1
#endif
#if DBG
namespace dbg {
using namespace fx;
template <class TT> __device__ __forceinline__ float ldt(const TT* p);
template <> __device__ __forceinline__ float ldt<float>(const float* p) { return *p; }
template <> __device__ __forceinline__ float ldt<unsigned short>(const unsigned short* p) { return bf2f(*p); }
template <class TT> __global__ void check_k(const float* __restrict__ ref, int ldr, const TT* __restrict__ test, int ldtst, int rows, int cols, float ts, float* acc, int id) {
    float d2 = 0.f, r2 = 0.f;
    for (size_t i = (size_t)blockIdx.x * 256 + threadIdx.x; i < (size_t)rows * cols; i += (size_t)gridDim.x * 256) { const size_t r = i / cols, c = i % cols;
        const float a = ref[r * ldr + c], b = ts * ldt<TT>(test + r * ldtst + c); const float d = a - b; d2 += d * d; r2 += a * a; }
    d2 = wave_sum(d2); r2 = wave_sum(r2);
    if ((threadIdx.x & 63) == 0) { atomicAdd(acc + 2 * id, d2); atomicAdd(acc + 2 * id + 1, r2); }
}
__global__ void verdict_k(float* acc, int id, float tol, int code, unsigned* flag, float* ratios) {
    const float ratio = acc[2 * id] / acc[2 * id + 1];
    ratios[id] = ratio;
    if (!(ratio <= tol)) atomicMax(flag, (unsigned)code);
}
__global__ void poison_k(const unsigned* flag, const float* ratios, float* m_s, int report) {
    const unsigned f = *flag; float s = 1.f;
    if (f) s = 1.f + (float)f; else if (report >= 0) s = 1.f + sqrtf(ratios[report]);
    m_s[threadIdx.x] *= s;
}
}
#endif

extern "C" void kernel_launch(void* const* d_in, const int* in_sizes, int n_in, void* d_out, int out_size, void* d_ws, size_t ws_size, hipStream_t stream) {
    using namespace fk;
    static int grid = 0;
    if (grid == 0) {
        int dev = 0, cus = 0, per_cu = 0;
        if (hipGetDevice(&dev) != hipSuccess || hipDeviceGetAttribute(&cus, hipDeviceAttributeMultiprocessorCount, dev) != hipSuccess) { fprintf(stderr, "kernel_launch: device query failed\n"); grid = -1; return; }
        if (hipFuncSetAttribute((const void*)fwd, hipFuncAttributeMaxDynamicSharedMemorySize, LDS_BYTES) != hipSuccess) { fprintf(stderr, "kernel_launch: hipFuncSetAttribute failed\n"); grid = -1; return; }
        if (hipOccupancyMaxActiveBlocksPerMultiprocessor(&per_cu, (const void*)fwd, NWAVES * 64, LDS_BYTES) != hipSuccess || per_cu < 1) fprintf(stderr, "kernel_launch: occupancy query reports %d\n", per_cu);
        (void)hipGetLastError();
        if (n_in != 34 || (size_t)out_size != OUT_FLOATS || ws_size < WS_FAST_END) { fprintf(stderr, "kernel_launch: shape mismatch n_in %d out %d ws %zu\n", n_in, out_size, ws_size); grid = -1; return; }
        grid = cus;
    }
    if (grid < 0) return;
    (void)hipMemsetAsync(d_ws, 0, CTL_ZERO_BYTES, stream);
    Args a{};
    for (int i = 0; i < 34; ++i) a.in[i] = d_in[i];
    a.ws = (unsigned char*)d_ws;
#if !DBG
    a.out = (float*)d_out; a.ph_lo = 0; a.ph_hi = NPHASE; a.use_bar = 1; a.pad = 0;
    hipLaunchKernelGGL(fwd, dim3(grid), dim3(NWAVES * 64), LDS_BYTES, stream, a);
#else
    constexpr size_t FOUT_OFF = (WS_FAST_END + 4095) / 4096 * 4096, NAIVE_OFF = (FOUT_OFF + OUT_FLOATS * 4 + 4095) / 4096 * 4096;
    float* fout = (float*)((char*)d_ws + FOUT_OFF); float* nws = (float*)((char*)d_ws + NAIVE_OFF);
    float* acc = (float*)((char*)d_ws + 49152); unsigned* flag = (unsigned*)(acc + 128); float* ratios = acc + 160;
    a.out = fout; a.use_bar = 0; a.pad = 0;
    const Out FO = carve_out(fout);
    unsigned char* ws = (unsigned char*)d_ws;
    auto phases = [&](int lo, int hi) { for (int p = lo; p < hi; ++p) { a.ph_lo = p; a.ph_hi = p + 1; hipLaunchKernelGGL(fwd, dim3(grid), dim3(NWAVES * 64), LDS_BYTES, stream, a); } };
    int next_id = 0;
    auto chk_f = [&](const float* ref, int ldr, const float* t, int ldtst, int rows, int cols, float ts, int code, float tol) { const int id = next_id++;
        dbg::check_k<float><<<1024, 256, 0, stream>>>(ref, ldr, t, ldtst, rows, cols, ts, acc, id); dbg::verdict_k<<<1, 1, 0, stream>>>(acc, id, tol, code, flag, ratios); };
    auto chk_b = [&](const float* ref, int ldr, const void* t, int ldtst, int rows, int cols, float ts, int code, float tol) { const int id = next_id++;
        dbg::check_k<unsigned short><<<1024, 256, 0, stream>>>(ref, ldr, (const unsigned short*)t, ldtst, rows, cols, ts, acc, id); dbg::verdict_k<<<1, 1, 0, stream>>>(acc, id, tol, code, flag, ratios); };
    const float TOL = 1e-3f;
    auto hook = [&](int stage, const nv::Ws& w, const nv::Out& NO) {
        if (stage == 1) { phases(0, 2); chk_b(w.G, FF, ws + O_ACT, FF, MT, FF, 1.f, 30, TOL); }
        else if (stage == 2) { phases(2, 3); chk_f(w.h1, DM, (const float*)(ws + O_H), DM, MT, DM, 1.f, 29, TOL); }
        else if (stage == 3) { phases(3, 4);
            chk_b(w.z + 384, 2728, ws + O_ZKV, KVL, MT, KVL, 1.f, 28, TOL);
            chk_b(w.z, 2728, ws + O_ZQ, QL, MT, QL, 1.f, 27, TOL);
            chk_b(w.z + 672, 2728, ws + O_MQ, 512, MT, 512, 1.f, 26, TOL);
            chk_b(w.z + 1184, 2728, ws + O_MK, 512, MT, 512, 11.313708498984761f, 25, TOL);
            chk_b(w.z + 1696, 2728, ws + O_MV, 512, MT, 512, 1.f, 24, TOL);
            chk_b(w.z + 2208, 2728, ws + O_MO, 512, MT, 512, 1.f, 23, TOL);
            chk_f(w.z + 2720, 2728, (const float*)(ws + O_GATES), 8, MT, 8, 1.f, 22, TOL);
            chk_f(NO.kr_p, RD, FO.kr_p, RD, MP, RD, 1.f, 21, TOL); chk_f(NO.kr_s, RD, FO.kr_s, RD, MS, RD, 1.f, 21, TOL); }
        else if (stage == 4) { phases(4, 5);
            chk_b(w.q, 768, ws + O_QB, 768, MT, 768, 1.f, 20, TOL);
            chk_b(w.v, 512, ws + O_VB, 512, MP, 512, 1.f, 19, TOL);
            chk_f(NO.ckv_p, KVL, FO.ckv_p, KVL, MP, KVL, 1.f, 18, TOL); chk_f(NO.ckv_s, KVL, FO.ckv_s, KVL, MS, KVL, 1.f, 18, TOL);
            chk_b(w.pp, DM, ws + O_PROJ, DM, MT, DM, 1.f, 17, TOL);
            chk_f(NO.C_s, 128, FO.C_s, 128, MS * MH * MD, 128, 1.f, 16, TOL); chk_f(NO.n_s, 128, FO.n_s, 128, MS * MH, 128, 1.f, 16, TOL); chk_f(NO.m_s, 4, FO.m_s, 4, MS, 4, 1.f, 16, TOL);
            chk_b(w.G + (size_t)MP * 512, 512, (const unsigned short*)(ws + O_AB0) + (size_t)MP * DM + 512, DM, MS, 512, 1.f, 15, TOL); }
        else if (stage == 5) { phases(5, 8);
            chk_f(NO.C_p, 128, FO.C_p, 128, NB * MH * MD, 128, 1.f, 14, TOL); chk_f(NO.n_p, 128, FO.n_p, 128, NB * MH, 128, 1.f, 13, TOL); chk_f(NO.m_p, 4, FO.m_p, 4, NB, 4, 1.f, 13, TOL);
            chk_b(w.G, 512, (const unsigned short*)(ws + O_AB0) + 512, DM, MP, 512, 1.f, 12, TOL);
            chk_b(w.att, 512, ws + O_AB0, DM, MP, 512, 1.f, 11, TOL);
            chk_b(w.att + (size_t)MP * 512, 512, (const unsigned short*)(ws + O_AB0) + (size_t)MP * DM, DM, MS, 512, 1.f, 10, TOL); }
        else if (stage == 6) { phases(8, 9); chk_f(w.h2, DM, (const float*)(ws + O_H), DM, MT, DM, 1.f, 9, TOL); }
        else if (stage == 7) { phases(9, 10); chk_b(w.G, FF, ws + O_ACT, FF, MT, FF, 1.f, 8, TOL); }
        else if (stage == 8) { phases(10, 11); chk_f(w.h3, DM, (const float*)(ws + O_H), DM, MT, DM, 1.f, 7, TOL); }
        else if (stage == 9) { phases(11, 13); chk_f(NO.y_p, DM, FO.y_p, DM, MP, DM, 1.f, 6, TOL); chk_f(NO.y_s, DM, FO.y_s, DM, MS, DM, 1.f, 5, TOL); }
    };
    nv::run(d_in, (float*)d_out, nws, stream, hook);
    dbg::poison_k<<<1, MS * MH, 0, stream>>>(flag, ratios, nv::carve_out((float*)d_out).m_s, DBG_REPORT);
#endif
    const hipError_t le = hipPeekAtLastError();
    if (le != hipSuccess) fprintf(stderr, "kernel_launch: launch failed: %s\n", hipGetErrorName(le));
}
```

```cpp
#define DBG 0
#define DBG_REPORT -1
#include <hip/hip_runtime.h>
#include <cstdio>
#include <cstdint>
#include <math.h>
#define LAS __attribute__((address_space(3)))
#define GAS __attribute__((address_space(1)))
namespace fx {
constexpr int DM = 1024, NB = 2, S = 8192, MP = NB * S, MS = 128, MT = MP + MS, MPAD = 16640, FF = 2816;
constexpr int QL = 384, KVL = 256, RD = 32, NH = 8, MH = 4, MD = 128, PLE = 256;
constexpr int NPAGE = 64, PAGE = 128, PAST = 8192;
constexpr float EPS = 1e-6f;
constexpr float LOG2E = 1.4426950408889634f;
constexpr float ATT_SCALE = 0.10206207261596575f;
typedef unsigned short bf16_t;
typedef short bf16x8 __attribute__((ext_vector_type(8)));
typedef short s16x4 __attribute__((ext_vector_type(4)));
typedef float f32x4 __attribute__((ext_vector_type(4)));
typedef float f32x16 __attribute__((ext_vector_type(16)));
typedef unsigned u32x4 __attribute__((ext_vector_type(4)));
typedef unsigned u32x2 __attribute__((ext_vector_type(2)));
__constant__ float ROPE_INV[16] = {1.f, 0.562341332f, 0.316227764f, 0.177827939f, 0.100000001f, 0.0562341325f, 0.0316227749f, 0.0177827943f,
                                   0.00999999978f, 0.00562341325f, 0.00316227763f, 0.00177827943f, 0.00100000005f, 0.000562341302f, 0.000316227757f, 0.00017782794f};
__device__ __forceinline__ unsigned cvt_pk_bf16(float lo, float hi) { unsigned r; asm volatile("v_cvt_pk_bf16_f32 %0, %1, %2" : "=v"(r) : "v"(lo), "v"(hi)); return r; }
__device__ __forceinline__ float bf2f(unsigned short b) { return __uint_as_float((unsigned)b << 16); }
__device__ __forceinline__ float bflo(unsigned w) { return __uint_as_float(w << 16); }
__device__ __forceinline__ float bfhi(unsigned w) { return __uint_as_float(w & 0xffff0000u); }
__device__ __forceinline__ float ld_f32_agent(const float* p) { return __uint_as_float(__hip_atomic_load((const unsigned*)p, __ATOMIC_RELAXED, __HIP_MEMORY_SCOPE_AGENT)); }
__device__ __forceinline__ float rstd_of(const float* rsq, int row, float invn) { return rsqrtf(ld_f32_agent(rsq + row) * invn + EPS); }
__device__ __forceinline__ float fast_sigmoid(float x) { return __builtin_amdgcn_rcpf(1.f + __builtin_amdgcn_exp2f(-x * LOG2E)); }
__device__ __forceinline__ int pos_of(int row) { return row < MP ? (row & (S - 1)) : PAST; }
__device__ __forceinline__ void rope_cs(int pos, int i, float& c, float& s) {
    const float ang = (float)pos * ROPE_INV[i];
    const float n = rintf(ang * 0.15915494309189535f);
    float r = fmaf(-n, 6.28125f, ang); r = fmaf(-n, 0.0019353071795864769f, r);
    c = __cosf(r); s = __sinf(r);
}
constexpr int ROPE_NPOS = PAST + 1;
__device__ __forceinline__ float wave_sum(float v) {
#pragma unroll
    for (int o = 1; o < 64; o <<= 1) v += __shfl_xor(v, o);
    return v;
}
__device__ __forceinline__ float log_sigmoid(float x) { return fminf(x, 0.f) - log1pf(__expf(-fabsf(x))); }
}
namespace pg8 {
using namespace fx;
#define PG8_LAS __attribute__((address_space(3)))
constexpr int BM = 256, BK = 64, HALF = 128, HTB = HALF * BK * 2  , STAGE_BYTES = 8 * HTB, NXCD = 8, WGM = 8;

__host__ __device__ __forceinline__ int lds_byte(int r, int c) { const int st = (r >> 4) * 2 + (c >> 5), rr = r & 15, cc = c & 31, ob = rr * 64 + cc * 2; return st * 1024 + (ob ^ (((ob >> 9) & 1) << 5)); }
__host__ __device__ __forceinline__ void stage_rc(int b, int& R, int& C) { const int st = b / 1024, sb = b % 1024, swz = sb ^ (((sb >> 9) & 1) << 5); R = (st >> 1) * 16 + swz / 64; C = (st & 1) * 32 + (swz % 64) / 2; }
__host__ __device__ __forceinline__ int perm32(int rho) { const int n = rho >> 4, i = rho & 15; return 8 * (i >> 2) + 4 * n + (i & 3); }

struct Unit { int pm, pn; };
struct Gemm { const bf16_t* A; const bf16_t* Bt; int M, N, K, lda, ldb; };

struct StaticOrder {
    int nM, nN, nwg, G, c;
    __host__ __device__ void init(int M, int N, int G_, int c_) { nM = M / BM; nN = N / BM; nwg = nM * nN; G = G_; c = c_; }
    __host__ __device__ bool next(int i, Unit& u) const {
        const long L = (long)i * G + c; if (L >= nwg) return false;
        int wgid = (int)L; { const int q = nwg / NXCD, r = nwg % NXCD, xcd = wgid % NXCD, off = wgid / NXCD; wgid = (xcd < r ? xcd * (q + 1) : r * (q + 1) + (xcd - r) * q) + off; }
        const int nig = WGM * nN, gid = wgid / nig, fm = gid * WGM, gsz = (nM - fm) < WGM ? (nM - fm) : WGM;
        u.pm = fm + ((wgid % nig) % gsz); u.pn = (wgid % nig) / gsz; return true;
    }
    __device__ __forceinline__ void a_ready(const Unit&) const {}
    __device__ __forceinline__ void done(const Unit&) const {}
};

typedef f32x4 Acc[2][2][4][2];
__device__ __forceinline__ u32x4 pack8(f32x4 a, f32x4 b) { u32x4 w; w.x = cvt_pk_bf16(a[0], a[1]); w.y = cvt_pk_bf16(a[2], a[3]); w.z = cvt_pk_bf16(b[0], b[1]); w.w = cvt_pk_bf16(b[2], b[3]); return w; }
__device__ __forceinline__ float sumsq8(f32x4 a, f32x4 b) { return (a[0] * a[0] + a[1] * a[1]) + (a[2] * a[2] + a[3] * a[3]) + (b[0] * b[0] + b[1] * b[1]) + (b[2] * b[2] + b[3] * b[3]); }
__device__ __forceinline__ void rowsq_atomic(float (&s)[2][4], float* rsq, int rowbase  , int fq) {
#pragma unroll
    for (int ai = 0; ai < 2; ++ai)
#pragma unroll
        for (int m = 0; m < 4; ++m) { s[ai][m] += __shfl_xor(s[ai][m], 16); s[ai][m] += __shfl_xor(s[ai][m], 32); }
    const float v0 = fq == 0 ? s[0][0] : fq == 1 ? s[0][2] : fq == 2 ? s[1][0] : s[1][2];
    const float v1 = fq == 0 ? s[0][1] : fq == 1 ? s[0][3] : fq == 2 ? s[1][1] : s[1][3];
    const int r0 = rowbase + (fq >> 1) * HALF + (fq & 1) * 32;
    unsafeAtomicAdd(rsq + r0, v0); unsafeAtomicAdd(rsq + r0 + 16, v1);
}
struct EpiBase { static constexpr bool PERM = true, AFTER_DRAIN = false, MIDSCALE = false; };

struct EpiSwiGLU : EpiBase {
    bf16_t* act; const float* rsq;
    __device__ __forceinline__ void operator()(const Acc& acc, const Unit& u, int wr, int wc, int fr, int fq) const {
        const int row0 = u.pm * BM + wr * 64 + fr, col0 = u.pn * HALF + wc * 32 + 8 * fq;
#pragma unroll
        for (int ai = 0; ai < 2; ++ai)
#pragma unroll
            for (int m = 0; m < 4; ++m) { const int row = row0 + ai * HALF + m * 16; const float rs = rstd_of(rsq, row, 1.f / DM);
                f32x4 o[2];
#pragma unroll
                for (int n = 0; n < 2; ++n) { const f32x4 g = acc[ai][0][m][n] * rs, up = acc[ai][1][m][n] * rs;
#pragma unroll
                    for (int i = 0; i < 4; ++i) o[n][i] = g[i] * fast_sigmoid(g[i]) * up[i]; }
                *(u32x4*)(act + (size_t)row * FF + col0) = pack8(o[0], o[1]); }
    }
};
template <int MODE> struct EpiResid : EpiBase {
    static constexpr bool MIDSCALE = (MODE == 1);
    const float* xp; const float* xs; float* H; bf16_t* AB; float* rsq; const float* rsqa;
    __device__ __forceinline__ void mid(Acc& acc, const Unit& u, int wr, int fr) const {
#pragma unroll
        for (int ai = 0; ai < 2; ++ai)
#pragma unroll
            for (int m = 0; m < 4; ++m) { const float rs = rstd_of(rsqa, u.pm * BM + ai * HALF + wr * 64 + m * 16 + fr, 1.f / 512.f);
#pragma unroll
                for (int bj = 0; bj < 2; ++bj)
#pragma unroll
                    for (int n = 0; n < 2; ++n) acc[ai][bj][m][n] *= rs; }
    }
    __device__ __forceinline__ void operator()(const Acc& acc, const Unit& u, int wr, int wc, int fr, int fq) const {
        const int row0 = u.pm * BM + wr * 64 + fr, col0 = u.pn * BM + wc * 32 + 8 * fq;
        float ss[2][4];
#pragma unroll
        for (int ai = 0; ai < 2; ++ai)
#pragma unroll
            for (int m = 0; m < 4; ++m) { const int row = row0 + ai * HALF + m * 16; float s = 0.f;
#pragma unroll
                for (int bj = 0; bj < 2; ++bj) { const int col = col0 + bj * HALF; float* hp = H + (size_t)row * DM + col;
                    f32x4 b0, b1;
                    if (MODE == 0) { const float* xr = row < MP ? xp + (size_t)row * DM + col : xs + (size_t)(row - MP) * DM + col;
                        if (row < MT) { b0 = *(const f32x4*)xr; b1 = *(const f32x4*)(xr + 4); } else { b0 = (f32x4){0.f, 0.f, 0.f, 0.f}; b1 = b0; } }
                    else { b0 = *(const f32x4*)hp; b1 = *(const f32x4*)(hp + 4); }
                    const float sc = (MODE == 1) ? 1.f : 0.5f;
                    const f32x4 o0 = b0 + acc[ai][bj][m][0] * sc, o1 = b1 + acc[ai][bj][m][1] * sc;
                    *(f32x4*)hp = o0; *(f32x4*)(hp + 4) = o1;
                    *(u32x4*)(AB + (size_t)row * DM + col) = pack8(o0, o1);
                    s += sumsq8(o0, o1); }
                ss[ai][m] = s; }
        rowsq_atomic(ss, rsq, row0, fq);
    }
};
struct EpiZ : EpiBase {
    const float* rsq1; const float* ROPE; bf16_t *ZKV, *ZQ, *KB, *MQ; size_t mstride; float* GATES; float *ckv_p, *ckv_s, *kr_p, *kr_s; float *rsqkv, *rsqq;
    __device__ __forceinline__ void operator()(const Acc& acc, const Unit& u, int wr, int wc, int fr, int fq) const {
        const int row0 = u.pm * BM + wr * 64 + fr, pn = u.pn, cw = wc * 32 + 8 * fq;
        float ss[2][4];
#pragma unroll
        for (int ai = 0; ai < 2; ++ai)
#pragma unroll
            for (int m = 0; m < 4; ++m) { const int row = row0 + ai * HALF + m * 16; const float rs = rstd_of(rsq1, row, 1.f / DM); float s = 0.f;
                const f32x4 a0 = acc[ai][0][m][0] * rs, a1 = acc[ai][0][m][1] * rs, c0 = acc[ai][1][m][0] * rs, c1 = acc[ai][1][m][1] * rs;
                if (pn == 0) {
                    *(u32x4*)(ZKV + (size_t)row * KVL + cw) = pack8(a0, a1); *(u32x4*)(ZKV + (size_t)row * KVL + HALF + cw) = pack8(c0, c1);
                    if (row < MT) { float* cp = row < MP ? ckv_p + (size_t)row * KVL + cw : ckv_s + (size_t)(row - MP) * KVL + cw;
                        *(f32x4*)cp = a0; *(f32x4*)(cp + 4) = a1; *(f32x4*)(cp + HALF) = c0; *(f32x4*)(cp + HALF + 4) = c1; }
                    s = sumsq8(a0, a1) + sumsq8(c0, c1);
                } else if (pn == 1) {
                    *(u32x4*)(ZQ + (size_t)row * QL + cw) = pack8(a0, a1); *(u32x4*)(ZQ + (size_t)row * QL + HALF + cw) = pack8(c0, c1);
                    s = sumsq8(a0, a1) + sumsq8(c0, c1);
                } else if (pn == 2) {
                    *(u32x4*)(ZQ + (size_t)row * QL + 256 + cw) = pack8(a0, a1);
                    s = sumsq8(a0, a1);
                    if (wc == 0) {
                        const float* tb = ROPE + (size_t)pos_of(row) * 32 + 4 * fq; const f32x4 cs = *(const f32x4*)tb, sn = *(const f32x4*)(tb + 16);
                        const f32x4 x1 = {c0[0], c0[2], c1[0], c1[2]}, x2 = {c0[1], c0[3], c1[1], c1[3]};
                        const f32x4 o1 = x1 * cs - x2 * sn, o2 = x1 * sn + x2 * cs;
                        if (row < MT) { float* kp = row < MP ? kr_p + (size_t)row * RD : kr_s + (size_t)(row - MP) * RD; *(f32x4*)(kp + 4 * fq) = o1; *(f32x4*)(kp + 16 + 4 * fq) = o2; }
                        if (row < MP) { u32x2 w1, w2; w1.x = cvt_pk_bf16(o1[0], o1[1]); w1.y = cvt_pk_bf16(o1[2], o1[3]); w2.x = cvt_pk_bf16(o2[0], o2[1]); w2.y = cvt_pk_bf16(o2[2], o2[3]);
#pragma unroll
                            for (int h = 0; h < NH; ++h) { bf16_t* kb = KB + (size_t)row * 768 + h * 96 + 64 + 4 * fq; *(u32x2*)kb = w1; *(u32x2*)(kb + 16) = w2; } }
                    } else if (wc == 1 && fq == 0) { *(f32x4*)(GATES + (size_t)row * 8) = c0; *(f32x4*)(GATES + (size_t)row * 8 + 4) = c1; }
                } else {
                    const int t = pn - 3; bf16_t* dst = MQ + (size_t)(t >> 1) * mstride;
                    bf16_t* dp = dst + (size_t)row * 512 + (t & 1) * 256 + cw;
                    *(u32x4*)dp = pack8(a0, a1); *(u32x4*)(dp + HALF) = pack8(c0, c1);
                }
                ss[ai][m] = s; asm volatile("" ::: "memory"); }
        if (pn == 0) rowsq_atomic(ss, rsqkv, row0, fq);
        else if (pn <= 2) rowsq_atomic(ss, rsqq, row0, fq);
    }
};
struct EpiQ : EpiBase {
    const float* rsqq; const float* ROPE; bf16_t* QB;
    __device__ __forceinline__ void operator()(const Acc& acc, const Unit& u, int wr, int wc, int fr, int fq) const {
        const int row0 = u.pm * BM + wr * 64 + fr;
#pragma unroll
        for (int ai = 0; ai < 2; ++ai)
#pragma unroll
            for (int m = 0; m < 4; ++m) { const int row = row0 + ai * HALF + m * 16; const float rs = rstd_of(rsqq, row, 1.f / QL); const int pos = pos_of(row);
#pragma unroll
                for (int bj = 0; bj < 2; ++bj) { const int c = u.pn * BM + bj * HALF + wc * 32 + 8 * fq, h = c / 96, d = c - h * 96;
                    const f32x4 v0 = acc[ai][bj][m][0] * rs, v1 = acc[ai][bj][m][1] * rs;
                    if (d < 64) *(u32x4*)(QB + (size_t)row * 768 + c) = pack8(v0, v1);
                    else { const int i0 = (d - 64) >> 1; const float* tb = ROPE + (size_t)pos * 32 + i0; const f32x4 cs = *(const f32x4*)tb, sn = *(const f32x4*)(tb + 16);
                        const f32x4 x1 = {v0[0], v0[2], v1[0], v1[2]}, x2 = {v0[1], v0[3], v1[1], v1[3]};
                        const f32x4 o1 = x1 * cs - x2 * sn, o2 = x1 * sn + x2 * cs;
                        u32x2 w1, w2; w1.x = cvt_pk_bf16(o1[0], o1[1]); w1.y = cvt_pk_bf16(o1[2], o1[3]); w2.x = cvt_pk_bf16(o2[0], o2[1]); w2.y = cvt_pk_bf16(o2[2], o2[3]);
                        bf16_t* qp = QB + (size_t)row * 768 + h * 96 + 64 + i0; *(u32x2*)qp = w1; *(u32x2*)(qp + 16) = w2; } }
                asm volatile("" ::: "memory"); }
    }
};
struct EpiKV : EpiBase {
    const float* rsqkv; bf16_t *KB, *VB; float *ckv_p, *ckv_s; const float* g_kv;
    __device__ __forceinline__ void operator()(const Acc& acc, const Unit& u, int wr, int wc, int fr, int fq) const {
        const int row0 = u.pm * BM + wr * 64 + fr;
#pragma unroll
        for (int ai = 0; ai < 2; ++ai)
#pragma unroll
            for (int m = 0; m < 4; ++m) { const int row = row0 + ai * HALF + m * 16; const float rs = rstd_of(rsqkv, row, 1.f / KVL);
#pragma unroll
                for (int bj = 0; bj < 2; ++bj) { const int c = u.pn * BM + bj * HALF + wc * 32 + 8 * fq;
                    const u32x4 w = pack8(acc[ai][bj][m][0] * rs, acc[ai][bj][m][1] * rs);
                    if (c < 512) *(u32x4*)(KB + (size_t)row * 768 + (c >> 6) * 96 + (c & 63)) = w; else *(u32x4*)(VB + (size_t)row * 512 + (c - 512)) = w; } }
        const int lane = fr + 16 * fq, wid = wr * 4 + wc, rl = (wid * 64 + lane) >> 1, row = u.pm * BM + rl, cb = u.pn * 64 + (lane & 1) * 32;
        if (row < MT) { float* cp = row < MP ? ckv_p + (size_t)row * KVL + cb : ckv_s + (size_t)(row - MP) * KVL + cb; const float rs = rstd_of(rsqkv, row, 1.f / KVL);
#pragma unroll
            for (int j = 0; j < 8; ++j) { const f32x4 g = *(const f32x4*)(g_kv + cb + 4 * j); f32x4 v = *(f32x4*)(cp + 4 * j); v = v * g * rs; *(f32x4*)(cp + 4 * j) = v; } }
    }
};
struct EpiPlain : EpiBase {
    bf16_t* O; int ldo;
    __device__ __forceinline__ void operator()(const Acc& acc, const Unit& u, int wr, int wc, int fr, int fq) const {
        const int row0 = u.pm * BM + wr * 64 + fr, col0 = u.pn * BM + wc * 32 + 8 * fq;
#pragma unroll
        for (int ai = 0; ai < 2; ++ai)
#pragma unroll
            for (int m = 0; m < 4; ++m)
#pragma unroll
                for (int bj = 0; bj < 2; ++bj) *(u32x4*)(O + (size_t)(row0 + ai * HALF + m * 16) * ldo + col0 + bj * HALF) = pack8(acc[ai][bj][m][0], acc[ai][bj][m][1]);
    }
};
struct EpiPle : EpiBase {
    const float* rsq3; const bf16_t* PROJ; const float* H; float *y_p, *y_s; float* rsq4;
    __device__ __forceinline__ void operator()(const Acc& acc, const Unit& u, int wr, int wc, int fr, int fq) const {
        const int row0 = u.pm * BM + wr * 64 + fr, col0 = u.pn * BM + wc * 32 + 8 * fq;
        float ss[2][4];
#pragma unroll
        for (int ai = 0; ai < 2; ++ai)
#pragma unroll
            for (int m = 0; m < 4; ++m) { const int row = row0 + ai * HALF + m * 16; const float rs = rstd_of(rsq3, row, 1.f / DM); float s = 0.f;
#pragma unroll
                for (int bj = 0; bj < 2; ++bj) { const int col = col0 + bj * HALF; const size_t off = (size_t)row * DM + col;
                    const u32x4 pw = *(const u32x4*)(PROJ + off); const f32x4 h0 = *(const f32x4*)(H + off), h1 = *(const f32x4*)(H + off + 4);
                    const f32x4 g0 = acc[ai][bj][m][0] * rs, g1 = acc[ai][bj][m][1] * rs; f32x4 o0, o1;
                    o0[0] = h0[0] + fast_sigmoid(g0[0]) * bflo(pw.x); o0[1] = h0[1] + fast_sigmoid(g0[1]) * bfhi(pw.x); o0[2] = h0[2] + fast_sigmoid(g0[2]) * bflo(pw.y); o0[3] = h0[3] + fast_sigmoid(g0[3]) * bfhi(pw.y);
                    o1[0] = h1[0] + fast_sigmoid(g1[0]) * bflo(pw.z); o1[1] = h1[1] + fast_sigmoid(g1[1]) * bfhi(pw.z); o1[2] = h1[2] + fast_sigmoid(g1[2]) * bflo(pw.w); o1[3] = h1[3] + fast_sigmoid(g1[3]) * bfhi(pw.w);
                    if (row < MT) { float* yp = row < MP ? y_p + off : y_s + (size_t)(row - MP) * DM + col; *(f32x4*)yp = o0; *(f32x4*)(yp + 4) = o1; }
                    s += sumsq8(o0, o1); }
                ss[ai][m] = s; }
        rowsq_atomic(ss, rsq4, row0, fq);
    }
};
template <class Epi, class Sched, bool ALIGN_EPI = false, bool SP2 = false>
__device__ __forceinline__ void gemm_phase(PG8_LAS unsigned char* lds, const Gemm g, const Sched& S, const Epi& E) {
    int tid_ = threadIdx.x; asm volatile("" : "+v"(tid_));
    const int tid = tid_, wid = __builtin_amdgcn_readfirstlane(tid >> 6), lane = tid & 63, wr = wid >> 2, wc = wid & 3, fr = lane & 15, fq = lane >> 4;
    const int K = g.K, nt = K / BK;
    unsigned voffA[2], voffB[2];
#pragma unroll
    for (int i = 0; i < 2; ++i) { int R, C; stage_rc(tid * 16 + i * 8192, R, C); const int Rb = Epi::PERM ? ((R & ~31) + perm32(R & 31)) : R;
        voffA[i] = (unsigned)(R * g.lda + C) * 2u; voffB[i] = (unsigned)(Rb * g.ldb + C) * 2u; }
    const size_t kstep = (size_t)(BK * 2);
    const size_t hstepA = (size_t)HALF * g.lda * 2, hstepB = (size_t)HALF * g.ldb * 2;
    const size_t tstepA = 2 * hstepA, tstepB = 2 * hstepB;
    const unsigned ldsw = (unsigned)wid * 1024u;
    const int aoff = lds_byte(wr * 64 + fr, fq * 8), boff = lds_byte(wc * 32 + fr, fq * 8);
#define PG8_SA(b, h) (((b) * 2 + (h)) * HTB)
#define PG8_SB(b, h) ((4 + (b) * 2 + (h)) * HTB)
#define PG8_STAGE(bufoff, gbase, voff) do { _Pragma("unroll") for (int _i = 0; _i < 2; ++_i) \
        __builtin_amdgcn_global_load_lds((const unsigned*)((const char*)(gbase) + (voff)[_i]), (PG8_LAS unsigned*)(lds + (bufoff) + ldsw + _i * 8192), 16, 0, 0); } while (0)
#define PG8_LDA(dst, b, h) do { _Pragma("unroll") for (int m = 0; m < 4; ++m) _Pragma("unroll") for (int k = 0; k < 2; ++k) dst[m][k] = *(const PG8_LAS bf16x8*)(lds + PG8_SA(b, h) + aoff + m * 2048 + k * 1024); } while (0)
#define PG8_LDB(dst, b, h) do { _Pragma("unroll") for (int n = 0; n < 2; ++n) _Pragma("unroll") for (int k = 0; k < 2; ++k) dst[n][k] = *(const PG8_LAS bf16x8*)(lds + PG8_SB(b, h) + boff + n * 2048 + k * 1024); } while (0)
#define PG8_MMA(ai, bj, At, Bt) do { __builtin_amdgcn_s_setprio(1); _Pragma("unroll") for (int m = 0; m < 4; ++m) _Pragma("unroll") for (int n = 0; n < 2; ++n) _Pragma("unroll") for (int k = 0; k < 2; ++k) \
        acc[ai][bj][m][n] = __builtin_amdgcn_mfma_f32_16x16x32_bf16(Bt[n][k], At[m][k], acc[ai][bj][m][n], 0, 0, 0); __builtin_amdgcn_s_setprio(0); } while (0)
#define PG8_WAIT_V(n) asm volatile("s_waitcnt vmcnt(" #n ")" ::: "memory")
#define PG8_WAIT_L(n) asm volatile("s_waitcnt lgkmcnt(" #n ")" ::: "memory")
#define PG8_BAR __builtin_amdgcn_s_barrier()
#define PG8_SCHED __builtin_amdgcn_sched_barrier(0)
    Unit cur, nxt; int ui = 0;
    if (!S.next(0, cur)) return;
    f32x4 acc[2][2][4][2];
#pragma unroll
    for (int a = 0; a < 2; ++a)
#pragma unroll
        for (int b = 0; b < 2; ++b)
#pragma unroll
            for (int m = 0; m < 4; ++m)
#pragma unroll
                for (int n = 0; n < 2; ++n) acc[a][b][m][n] = (f32x4){0.f, 0.f, 0.f, 0.f};
    bf16x8 At[4][2], B0[2][2], B1[2][2];
    const char* cA = (const char*)g.A + (size_t)cur.pm * tstepA; const char* cB = (const char*)g.Bt + (size_t)cur.pn * tstepB;
    S.a_ready(cur);
    if constexpr (SP2) {
        PG8_STAGE(PG8_SB(0, 0), cB, voffB); PG8_STAGE(PG8_SB(0, 1), cB + hstepB, voffB); PG8_STAGE(PG8_SA(0, 0), cA, voffA); PG8_STAGE(PG8_SA(0, 1), cA + hstepA, voffA);
        if (wr == 1) PG8_BAR;
        PG8_WAIT_V(2); PG8_BAR;
        PG8_STAGE(PG8_SB(1, 0), cB + kstep, voffB); PG8_STAGE(PG8_SA(1, 0), cA + kstep, voffA); PG8_STAGE(PG8_SB(1, 1), cB + hstepB + kstep, voffB);
        PG8_WAIT_V(6); PG8_BAR;
    } else {
        PG8_STAGE(PG8_SB(0, 0), cB, voffB); PG8_STAGE(PG8_SA(0, 0), cA, voffA); PG8_STAGE(PG8_SB(0, 1), cB + hstepB, voffB); PG8_STAGE(PG8_SA(0, 1), cA + hstepA, voffA);
        if (wr == 1) PG8_BAR;
        PG8_WAIT_V(4); PG8_BAR;
        PG8_STAGE(PG8_SB(1, 0), cB + kstep, voffB); PG8_STAGE(PG8_SA(1, 0), cA + kstep, voffA); PG8_STAGE(PG8_SB(1, 1), cB + hstepB + kstep, voffB);
        PG8_WAIT_V(6); PG8_BAR;
    }
    for (;;) {
        const bool has_next = S.next(ui + 1, nxt);
        const char* nA = has_next ? (const char*)g.A + (size_t)nxt.pm * tstepA : cA; const char* nB = has_next ? (const char*)g.Bt + (size_t)nxt.pn * tstepB : cB;
#pragma nounroll
        for (int t = 0; t < nt; t += 2) {
            const bool last = (t == nt - 2);
            if constexpr (Epi::MIDSCALE) { if (t == (nt >> 1)) E.mid(acc, cur, wr, fr); }
            const char* a1 = cA + (size_t)(t + 1) * kstep;
            const char* a2 = last ? nA : cA + (size_t)(t + 2) * kstep; const char* b2 = last ? nB : cB + (size_t)(t + 2) * kstep;
            const char* a3 = a2 + kstep; const char* b3 = b2 + kstep;
            if (last && has_next) S.a_ready(nxt);
            if constexpr (SP2) {
            PG8_LDB(B0, 0, 0); PG8_LDB(B1, 0, 1); PG8_SCHED; PG8_LDA(At, 0, 0); PG8_STAGE(PG8_SA(1, 1), a1 + hstepA, voffA);
            PG8_WAIT_V(8); PG8_WAIT_L(0); PG8_BAR; PG8_MMA(0, 0, At, B0); PG8_MMA(0, 1, At, B1); PG8_BAR; PG8_SCHED;
            PG8_LDA(At, 0, 1); PG8_STAGE(PG8_SB(0, 0), b2, voffB); PG8_STAGE(PG8_SB(0, 1), b2 + hstepB, voffB); PG8_STAGE(PG8_SA(0, 0), a2, voffA);
            PG8_WAIT_V(8); PG8_WAIT_L(0); PG8_BAR; PG8_MMA(1, 0, At, B0); PG8_MMA(1, 1, At, B1); PG8_BAR; PG8_SCHED;
            PG8_LDB(B0, 1, 0); PG8_LDB(B1, 1, 1); PG8_SCHED; PG8_LDA(At, 1, 0); PG8_STAGE(PG8_SA(0, 1), a2 + hstepA, voffA);
            PG8_WAIT_V(8); PG8_WAIT_L(0); PG8_BAR; PG8_MMA(0, 0, At, B0); PG8_MMA(0, 1, At, B1); PG8_BAR; PG8_SCHED;
            PG8_LDA(At, 1, 1); PG8_STAGE(PG8_SB(1, 0), b3, voffB); PG8_STAGE(PG8_SB(1, 1), b3 + hstepB, voffB); PG8_STAGE(PG8_SA(1, 0), a3, voffA);
            PG8_WAIT_V(8); PG8_WAIT_L(0); PG8_BAR; PG8_MMA(1, 0, At, B0); PG8_MMA(1, 1, At, B1); PG8_BAR; PG8_SCHED;
            } else {
            PG8_LDB(B0, 0, 0); PG8_SCHED; PG8_LDA(At, 0, 0); PG8_STAGE(PG8_SA(1, 1), a1 + hstepA, voffA);
            PG8_WAIT_L(8); PG8_BAR; PG8_WAIT_L(0); PG8_MMA(0, 0, At, B0); PG8_BAR; PG8_SCHED;
            PG8_LDB(B1, 0, 1); PG8_STAGE(PG8_SB(0, 0), b2, voffB);
            PG8_BAR; PG8_WAIT_L(0); PG8_MMA(0, 1, At, B1); PG8_BAR;
            PG8_LDA(At, 0, 1); PG8_STAGE(PG8_SA(0, 0), a2, voffA);
            PG8_BAR; PG8_WAIT_L(0); PG8_MMA(1, 0, At, B0); PG8_BAR; PG8_SCHED;
            PG8_STAGE(PG8_SB(0, 1), b2 + hstepB, voffB);
            PG8_WAIT_V(6); PG8_BAR; PG8_MMA(1, 1, At, B1); PG8_BAR;
            PG8_LDB(B0, 1, 0); PG8_SCHED; PG8_LDA(At, 1, 0); PG8_STAGE(PG8_SA(0, 1), a2 + hstepA, voffA);
            PG8_WAIT_L(8); PG8_BAR; PG8_WAIT_L(0); PG8_MMA(0, 0, At, B0); PG8_BAR; PG8_SCHED;
            PG8_LDB(B1, 1, 1); PG8_STAGE(PG8_SB(1, 0), b3, voffB);
            PG8_BAR; PG8_WAIT_L(0); PG8_MMA(0, 1, At, B1); PG8_BAR;
            PG8_LDA(At, 1, 1); PG8_STAGE(PG8_SA(1, 0), a3, voffA);
            PG8_BAR; PG8_WAIT_L(0); PG8_MMA(1, 0, At, B0); PG8_BAR; PG8_SCHED;
            PG8_STAGE(PG8_SB(1, 1), b3 + hstepB, voffB);
            PG8_WAIT_V(6); PG8_BAR; PG8_MMA(1, 1, At, B1); PG8_BAR;
            }
        }
        if constexpr (ALIGN_EPI) { if (wr == 0) PG8_BAR; }
        if constexpr (!Epi::AFTER_DRAIN) { E(acc, cur, wr, wc, fr, fq); S.done(cur); }
        if (!has_next) break;
#pragma unroll
        for (int a = 0; a < 2; ++a)
#pragma unroll
            for (int b = 0; b < 2; ++b)
#pragma unroll
                for (int m = 0; m < 4; ++m)
#pragma unroll
                    for (int n = 0; n < 2; ++n) acc[a][b][m][n] = (f32x4){0.f, 0.f, 0.f, 0.f};
        cur = nxt; cA = nA; cB = nB; ++ui;
        if constexpr (ALIGN_EPI) { if (wr == 1) PG8_BAR; }
    }
    PG8_WAIT_V(0);
    if constexpr (!ALIGN_EPI) { if (wr == 0) PG8_BAR; }
    PG8_BAR;
    if constexpr (Epi::AFTER_DRAIN) { E.fused(acc, cur, wr, wc, fr, fq, lds, wid, lane); S.done(cur); }
#undef PG8_SA
#undef PG8_SB
#undef PG8_STAGE
#undef PG8_LDA
#undef PG8_LDB
#undef PG8_MMA
#undef PG8_WAIT_V
#undef PG8_WAIT_L
#undef PG8_BAR
#undef PG8_SCHED
}
}
namespace att {
using namespace fx;
constexpr int QBLK = 32, NW = 8, KVBLK = 64, QB_ROWS = QBLK * NW;
constexpr int QP = 768, KP = 768, VP = 512, OP = 1024;
constexpr float THR = 8.f;
constexpr int SHM_K = KVBLK * 256, SHM_V = KVBLK * 256;
constexpr int LDS_V = 0, LDS_K = 2 * SHM_V, LDS_WS = 2 * SHM_V + 2 * SHM_K, LDS_OST = LDS_WS + NW * 64 * 4, LDS_BYTES = LDS_OST + NW * 4096;
#define KSWZ(row, colB) ((row) * 256 + ((colB) ^ (((row) & 7) << 4)))
#define SBAR() __builtin_amdgcn_sched_barrier(0)
__device__ __forceinline__ int crow(int r, int hi) { return (r & 3) + 8 * (r >> 2) + 4 * hi; }
__device__ __forceinline__ unsigned cvtpk(float lo, float hi) { unsigned r; asm volatile("v_cvt_pk_bf16_f32 %0, %1, %2" : "=v"(r) : "v"(lo), "v"(hi)); return r; }
__device__ __forceinline__ void partialSM(f32x16& p0, f32x16& p1, float& m_reg, float& mn, float& alpha, bool band, int kbase, int qrow, int hi) {
    constexpr float C = ATT_SCALE * LOG2E;
    if (band) {
#pragma unroll
        for (int r = 0; r < 16; ++r) { const int kv = kbase + crow(r, hi); if (kv > qrow) p0[r] = -INFINITY; if (kv + 32 > qrow) p1[r] = -INFINITY; }
    }
    float pmax = p0[0];
#pragma unroll
    for (int r = 1; r < 16; ++r) pmax = fmaxf(pmax, p0[r]);
#pragma unroll
    for (int r = 0; r < 16; ++r) pmax = fmaxf(pmax, p1[r]);
    { auto rr = __builtin_amdgcn_permlane32_swap(__float_as_uint(pmax), __float_as_uint(pmax), false, false);
      pmax = fmaxf(__uint_as_float(rr[0]), __uint_as_float(rr[1])); }
    if (__builtin_expect(__all(pmax - m_reg <= THR / ATT_SCALE), 1)) { mn = m_reg; alpha = 1.f; }
    else { mn = fmaxf(m_reg, pmax); alpha = __builtin_amdgcn_exp2f((m_reg - mn) * C); m_reg = mn; }
    const float mnC = -mn * C;
#pragma unroll
    for (int r = 0; r < 16; ++r) p0[r] = fmaf(p0[r], C, mnC);
#pragma unroll
    for (int r = 0; r < 16; ++r) p1[r] = fmaf(p1[r], C, mnC);
#pragma unroll
    for (int r = 0; r < 16; ++r) p0[r] = __builtin_amdgcn_exp2f(p0[r]);
}
#define ATT_PK4(P, BASE, OUT) do { unsigned a0 = cvtpk(P[BASE + 0], P[BASE + 1]), a1 = cvtpk(P[BASE + 2], P[BASE + 3]);   \
    unsigned b0 = cvtpk(P[BASE + 4], P[BASE + 5]), b1 = cvtpk(P[BASE + 6], P[BASE + 7]);                              \
    auto r0 = __builtin_amdgcn_permlane32_swap(a0, b0, false, false); auto r1 = __builtin_amdgcn_permlane32_swap(a1, b1, false, false); \
    u32x4 w = {r0[0], r1[0], r0[1], r1[1]}; OUT = *reinterpret_cast<bf16x8*>(&w); } while (0)
__device__ __forceinline__ void finishSM(f32x16& p0, f32x16& p1, float alpha, float& l_reg, bf16x8& pa0, bf16x8& pa1, bf16x8& pa2, bf16x8& pa3) {
#pragma unroll
    for (int r = 0; r < 16; ++r) p1[r] = __builtin_amdgcn_exp2f(p1[r]);
    float ps = 0;
#pragma unroll
    for (int r = 0; r < 16; ++r) ps += p0[r];
#pragma unroll
    for (int r = 0; r < 16; ++r) ps += p1[r];
    { auto rr = __builtin_amdgcn_permlane32_swap(__float_as_uint(ps), __float_as_uint(ps), false, false);
      ps = __uint_as_float(rr[0]) + __uint_as_float(rr[1]); }
    l_reg = l_reg * alpha + ps;
    ATT_PK4(p0, 0, pa0); ATT_PK4(p0, 8, pa1); ATT_PK4(p1, 0, pa2); ATT_PK4(p1, 8, pa3);
}
template <int ND0> __device__ __forceinline__ void qkt(f32x16& p0, f32x16& p1, const char* Ks, const bf16x8* qr, int r32, int hi) {
    p0 = f32x16{}; p1 = f32x16{};
#pragma unroll
    for (int d0 = 0; d0 < ND0; ++d0) { const int cb = (d0 * 16 + hi * 8) * 2;
        const bf16x8 b0 = *reinterpret_cast<const bf16x8*>(Ks + KSWZ(r32, cb));
        const bf16x8 b1 = *reinterpret_cast<const bf16x8*>(Ks + KSWZ(32 + r32, cb));
        p0 = __builtin_amdgcn_mfma_f32_32x32x16_bf16(b0, qr[d0], p0, 0, 0, 0);
        p1 = __builtin_amdgcn_mfma_f32_32x32x16_bf16(b1, qr[d0], p1, 0, 0, 0); }
}
__device__ __forceinline__ int v_st(int k, int c) { const int kk = (k & ~0xC) | ((k & 4) << 1) | ((k & 8) >> 1); return ((kk >> 3) * 4 + (c >> 5)) * 512 + ((kk & 7) * 32 + (c & 31)) * 2; }
__device__ __forceinline__ int v_rd_base(int lane) { return ((lane & 3) << 3) | (((lane >> 2) & 3) << 6) | (((lane >> 4) & 1) << 5) | (((lane >> 5) & 1) << 8); }
constexpr int v_rd_off(int d0, int ks, int half) { return d0 * 512 + ks * 4096 + half * 2048; }
template <int OFF> __device__ __forceinline__ s16x4 tr_read(int vb) {
    s16x4 r; asm volatile("ds_read_b64_tr_b16 %0, %1 offset:%2" : "=&v"(r) : "v"(vb), "i"(OFF) : "memory"); return r;
}
#define ATT_PK(L, H) (bf16x8){L[0], L[1], L[2], L[3], H[0], H[1], H[2], H[3]}
template <int D0> __device__ __forceinline__ void pv_one(f32x16& od, int vb, bf16x8 pa0, bf16x8 pa1, bf16x8 pa2, bf16x8 pa3) {
    const s16x4 l0 = tr_read<v_rd_off(D0, 0, 0)>(vb), h0 = tr_read<v_rd_off(D0, 0, 1)>(vb), l1 = tr_read<v_rd_off(D0, 1, 0)>(vb), h1 = tr_read<v_rd_off(D0, 1, 1)>(vb);
    const s16x4 l2 = tr_read<v_rd_off(D0, 2, 0)>(vb), h2 = tr_read<v_rd_off(D0, 2, 1)>(vb), l3 = tr_read<v_rd_off(D0, 3, 0)>(vb), h3 = tr_read<v_rd_off(D0, 3, 1)>(vb);
    asm volatile("s_waitcnt lgkmcnt(0)" ::: "memory"); SBAR();
    od = __builtin_amdgcn_mfma_f32_32x32x16_bf16(pa0, ATT_PK(l0, h0), od, 0, 0, 0);
    od = __builtin_amdgcn_mfma_f32_32x32x16_bf16(pa1, ATT_PK(l1, h1), od, 0, 0, 0);
    od = __builtin_amdgcn_mfma_f32_32x32x16_bf16(pa2, ATT_PK(l2, h2), od, 0, 0, 0);
    od = __builtin_amdgcn_mfma_f32_32x32x16_bf16(pa3, ATT_PK(l3, h3), od, 0, 0, 0);
}
__device__ __forceinline__ void attn_unit(int b, int h, int qb, const bf16_t* __restrict__ Q, const bf16_t* __restrict__ K, const bf16_t* __restrict__ V,
                                          bf16_t* __restrict__ O, float* __restrict__ rsqa, char* lds) {
    int tid_ = threadIdx.x; asm volatile("" : "+v"(tid_));
    const int tid = tid_, wid = tid >> 6, lane = tid & 63, r32 = lane & 31, hi = lane >> 5;
    const long rowbase = (long)b * S; const int q0 = qb * QB_ROWS;
    char* V_lds = lds + LDS_V; char* K_lds = lds + LDS_K;
    float* ws = (float*)(lds + LDS_WS) + wid * 64; float* li_l = ws; float* al_l = ws + 32;
    const bf16_t* Kh = K + rowbase * KP + h * 96; const bf16_t* Vh = V + rowbase * VP + h * 64;
    float m_reg = -1e30f, l_reg = 0; f32x16 o[2] = {}; bf16x8 qr[6];
    const bf16_t* Qw = Q + (rowbase + q0 + wid * QBLK + r32) * QP + h * 96 + hi * 8;
#pragma unroll
    for (int d0 = 0; d0 < 6; ++d0) qr[d0] = *reinterpret_cast<const bf16x8*>(Qw + d0 * 16);
    const int srA = tid >> 3, scA = tid & 7, srB = (tid & 255) >> 2, scB = 8 + (tid & 3);
    const int kstA = KSWZ(srA, scA * 16), kstB = KSWZ(srB, scB * 16), vst = v_st(srA, scA * 8);
    const int vb0 = (int)(uintptr_t)V_lds + v_rd_base(lane);
    bf16x8 ka[2], kb[2], vv[2];
#define SLOAD(i, k0) do { ka[i] = *reinterpret_cast<const bf16x8*>(Kh + (long)((k0) + srA) * KP + scA * 8); kb[i] = *reinterpret_cast<const bf16x8*>(Kh + (long)((k0) + srB) * KP + scB * 8); \
    vv[i] = *reinterpret_cast<const bf16x8*>(Vh + (long)((k0) + srA) * VP + scA * 8); } while (0)
#define SWRITE(bf, i) do { *(bf16x8*)(K_lds + (bf) * SHM_K + kstA) = ka[i]; *(bf16x8*)(K_lds + (bf) * SHM_K + kstB) = kb[i]; *(bf16x8*)(V_lds + (bf) * SHM_V + vst) = vv[i]; } while (0)
#define RESC(a) do { if (__any((a) < 1.f)) { if (hi == 0) al_l[r32] = (a); asm volatile("s_waitcnt lgkmcnt(0)" ::: "memory"); \
    _Pragma("unroll") for (int d = 0; d < 2; ++d) _Pragma("unroll") for (int r = 0; r < 16; ++r) o[d][r] *= al_l[crow(r, hi)]; } } while (0)
    f32x16 pA0, pA1, pB0, pB1; float mnA, mnB, alA, alB; bf16x8 pa0, pa1, pa2, pa3;
    const int NT = (q0 + QB_ROWS) / KVBLK;
    const int qrow = q0 + wid * QBLK + r32;
    constexpr int SE = 0, SO = 1;
    SLOAD(SE, 0); asm volatile("s_waitcnt vmcnt(0)" ::: "memory"); SWRITE(0, SE); __syncthreads();
    qkt<6>(pA0, pA1, K_lds, qr, r32, hi); partialSM(pA0, pA1, m_reg, mnA, alA, NT <= 4, 0, qrow, hi);
    SLOAD(SO, KVBLK); if (2 < NT) SLOAD(SE, 2 * KVBLK);
    SWRITE(1, SO); __syncthreads();
    for (int j = 1; j + 1 < NT; j += 2) {
        SBAR(); qkt<6>(pB0, pB1, K_lds + SHM_K, qr, r32, hi);
        finishSM(pA0, pA1, alA, l_reg, pa0, pa1, pa2, pa3); SBAR();
        SLOAD(SO, (j + 2) * KVBLK); SBAR();
        pv_one<0>(o[0], vb0, pa0, pa1, pa2, pa3); pv_one<1>(o[1], vb0, pa0, pa1, pa2, pa3);
        partialSM(pB0, pB1, m_reg, mnB, alB, j >= NT - 4, j * KVBLK, qrow, hi);
        __syncthreads(); SWRITE(0, SE);
        RESC(alB); __syncthreads();
        SBAR(); qkt<6>(pA0, pA1, K_lds, qr, r32, hi);
        finishSM(pB0, pB1, alB, l_reg, pa0, pa1, pa2, pa3); SBAR();
        if (j + 3 < NT) SLOAD(SE, (j + 3) * KVBLK); SBAR();
        pv_one<0>(o[0], vb0 + SHM_V, pa0, pa1, pa2, pa3); pv_one<1>(o[1], vb0 + SHM_V, pa0, pa1, pa2, pa3);
        partialSM(pA0, pA1, m_reg, mnA, alA, j + 1 >= NT - 4, (j + 1) * KVBLK, qrow, hi);
        __syncthreads(); SWRITE(1, SO);
        RESC(alA); __syncthreads();
    }
    SBAR(); qkt<6>(pB0, pB1, K_lds + SHM_K, qr, r32, hi);
    finishSM(pA0, pA1, alA, l_reg, pa0, pa1, pa2, pa3); SBAR();
    pv_one<0>(o[0], vb0, pa0, pa1, pa2, pa3); pv_one<1>(o[1], vb0, pa0, pa1, pa2, pa3);
    partialSM(pB0, pB1, m_reg, mnB, alB, true, (NT - 1) * KVBLK, qrow, hi);
    __syncthreads(); RESC(alB);
    finishSM(pB0, pB1, alB, l_reg, pa0, pa1, pa2, pa3); SBAR();
    pv_one<0>(o[0], vb0 + SHM_V, pa0, pa1, pa2, pa3); pv_one<1>(o[1], vb0 + SHM_V, pa0, pa1, pa2, pa3);
    if (hi == 0) li_l[r32] = l_reg; asm volatile("s_waitcnt lgkmcnt(0)" ::: "memory");
    float rli[16];
#pragma unroll
    for (int r = 0; r < 16; ++r) rli[r] = __builtin_amdgcn_rcpf(li_l[crow(r, hi)]);
    int zo = 0; asm volatile("" : "+v"(zo));
    bf16_t* stg = (bf16_t*)(lds + LDS_OST) + wid * 2048 + zo;
#pragma unroll
    for (int r = 0; r < 16; ++r) { const int orow = crow(r, hi);
#pragma unroll
        for (int d0 = 0; d0 < 2; ++d0) { const float v = o[d0][r] * rli[r]; stg[orow * 64 + d0 * 32 + r32] = (bf16_t)(cvtpk(v, v) & 0xffffu); } }
    asm volatile("s_waitcnt lgkmcnt(0)" ::: "memory");
    bf16_t* Ow = O + (rowbase + q0 + wid * QBLK) * OP + h * 64 + zo;
#pragma unroll
    for (int i = 0; i < 4; ++i) { const int row = i * 8 + (lane >> 3), ch = lane & 7; const u32x4 v = *(const u32x4*)(stg + row * 64 + ch * 8);
        *(u32x4*)(Ow + (long)row * OP + ch * 8) = v;
        float s = bflo(v.x) * bflo(v.x) + bfhi(v.x) * bfhi(v.x) + bflo(v.y) * bflo(v.y) + bfhi(v.y) * bfhi(v.y) + bflo(v.z) * bflo(v.z) + bfhi(v.z) * bfhi(v.z) + bflo(v.w) * bflo(v.w) + bfhi(v.w) * bfhi(v.w);
        s += __shfl_xor(s, 1); s += __shfl_xor(s, 2); s += __shfl_xor(s, 4);
        if (ch == 0) unsafeAtomicAdd(rsqa + rowbase + q0 + wid * QBLK + row, s); }
    __syncthreads();
#undef SLOAD
#undef SWRITE
#undef RESC
}
}
namespace ml {
using namespace fx;
using att::crow; using att::v_st; using att::v_rd_base; using att::v_rd_off; using att::tr_read; using att::cvtpk;
constexpr int NCH = S / 128, NUNIT = NB * MH * NCH;
struct Small { float lf[128], ig[128], at[128], cm[128], bt[128], ws[128], nn[128], red[256]; float sc[8]; };
static_assert(sizeof(Small) <= 8192, "Small");
__device__ __forceinline__ void chunk_gates(LAS Small* sm, const float* __restrict__ GATES, const float* __restrict__ b_i, const float* __restrict__ b_f, long row0, int h, int ltid) {
    if (ltid < 128) { const float* g = GATES + (row0 + ltid) * 8; sm->ig[ltid] = g[h] + b_i[h]; sm->lf[ltid] = log_sigmoid(g[4 + h] + b_f[h]); }
    __syncthreads();
    if (ltid == 0) { float b = 0.f, am = -INFINITY;
        for (int t = 0; t < 128; ++t) { b += sm->lf[t]; const float a = sm->ig[t] - b; am = fmaxf(am, a); sm->bt[t] = b; sm->at[t] = a; sm->cm[t] = am; }
        sm->sc[0] = am; sm->sc[1] = b; }
    __syncthreads();
}
__device__ __forceinline__ bf16x8 scale8(bf16x8 v, float w) {
    const u32x4 x = __builtin_bit_cast(u32x4, v); u32x4 y;
    y.x = cvt_pk_bf16(bflo(x.x) * w, bfhi(x.x) * w); y.y = cvt_pk_bf16(bflo(x.y) * w, bfhi(x.y) * w); y.z = cvt_pk_bf16(bflo(x.z) * w, bfhi(x.z) * w); y.w = cvt_pk_bf16(bflo(x.w) * w, bfhi(x.w) * w);
    return __builtin_bit_cast(bf16x8, y);
}
__device__ __forceinline__ void local_pair(int pr, const bf16_t* __restrict__ MK, const bf16_t* __restrict__ MV, const float* __restrict__ GATES, const float* __restrict__ b_i, const float* __restrict__ b_f,
                                           float* __restrict__ DCT, float* __restrict__ DN, float* __restrict__ ALAST, float* __restrict__ BL, char* lds, LAS Small* smb) {
    int tid_ = threadIdx.x; asm volatile("" : "+v"(tid_));
    const int tid = tid_, wid = tid >> 6, lane = tid & 63, r32 = lane & 31, hi = lane >> 5, hb = wid >> 2, w4 = wid & 3, ltid = tid & 255;
    const int u = 2 * pr + hb, bh = u >> 6, c = u & 63, b = bh >> 2, h = bh & 3;
    const long row0 = (long)b * S + c * 128;
    LAS Small* sm = smb + hb;
    char* Kimg = lds + hb * 65536; char* Vimg = Kimg + 32768;
    chunk_gates(sm, GATES, b_i, b_f, row0, h, ltid);
    const float alast = sm->sc[0];
    if (ltid < 128) sm->ws[ltid] = __expf(sm->at[ltid] - alast);
    if (ltid == 0) { ALAST[u] = alast; BL[u] = sm->sc[1]; }
    __syncthreads();
    { const int ch = ltid & 15;
#pragma unroll
      for (int i = 0; i < 8; ++i) { const int r = (ltid >> 4) + 16 * i; const size_t g = (size_t)(row0 + r) * 512 + h * 128 + ch * 8;
          const bf16x8 kv = *reinterpret_cast<const bf16x8*>(MK + g), vv = *reinterpret_cast<const bf16x8*>(MV + g);
          const int off = (r >> 6) * 16384 + v_st(r & 63, ch * 8);
          *(bf16x8*)(Kimg + off) = scale8(kv, sm->ws[r]); *(bf16x8*)(Vimg + off) = vv; } }
    __syncthreads();
    f32x16 acc[4] = {};
    const int vbV = (int)(uintptr_t)Vimg + v_rd_base(lane) + w4 * 512, vbK = (int)(uintptr_t)Kimg + v_rd_base(lane);
#define ML_STEP(T, KS) do { const int tv = vbV + (T) * 16384, tk = vbK + (T) * 16384; \
        const s16x4 al = tr_read<v_rd_off(0, KS, 0)>(tv), ah = tr_read<v_rd_off(0, KS, 1)>(tv); \
        const s16x4 b0l = tr_read<v_rd_off(0, KS, 0)>(tk), b0h = tr_read<v_rd_off(0, KS, 1)>(tk), b1l = tr_read<v_rd_off(1, KS, 0)>(tk), b1h = tr_read<v_rd_off(1, KS, 1)>(tk); \
        const s16x4 b2l = tr_read<v_rd_off(2, KS, 0)>(tk), b2h = tr_read<v_rd_off(2, KS, 1)>(tk), b3l = tr_read<v_rd_off(3, KS, 0)>(tk), b3h = tr_read<v_rd_off(3, KS, 1)>(tk); \
        asm volatile("s_waitcnt lgkmcnt(0)" ::: "memory"); __builtin_amdgcn_sched_barrier(0); \
        const bf16x8 A = ATT_PK(al, ah); \
        acc[0] = __builtin_amdgcn_mfma_f32_32x32x16_bf16(A, ATT_PK(b0l, b0h), acc[0], 0, 0, 0); acc[1] = __builtin_amdgcn_mfma_f32_32x32x16_bf16(A, ATT_PK(b1l, b1h), acc[1], 0, 0, 0); \
        acc[2] = __builtin_amdgcn_mfma_f32_32x32x16_bf16(A, ATT_PK(b2l, b2h), acc[2], 0, 0, 0); acc[3] = __builtin_amdgcn_mfma_f32_32x32x16_bf16(A, ATT_PK(b3l, b3h), acc[3], 0, 0, 0); } while (0)
    ML_STEP(0, 0); ML_STEP(0, 1); ML_STEP(0, 2); ML_STEP(0, 3); ML_STEP(1, 0); ML_STEP(1, 1); ML_STEP(1, 2); ML_STEP(1, 3);
#undef ML_STEP
    float* dct = DCT + (size_t)u * 16384;
#pragma unroll
    for (int d = 0; d < 4; ++d)
#pragma unroll
        for (int r = 0; r < 16; ++r) dct[(32 * w4 + crow(r, hi)) * 128 + 32 * d + r32] = acc[d][r];
    { const int dk = ltid & 127, hs = ltid >> 7; float s = 0.f;
      for (int k = 0; k < 64; ++k) s += bf2f(*(const bf16_t*)(Kimg + hs * 16384 + v_st(k, dk)));
      sm->red[ltid] = s; }
    __syncthreads();
    if (ltid < 128) DN[(size_t)u * 128 + ltid] = sm->red[ltid] + sm->red[128 + ltid];
    __syncthreads();
}
__device__ __forceinline__ void scan_all(int vcu, int G, const float* __restrict__ DCT, const float* __restrict__ DN, const float* __restrict__ ALAST, const float* __restrict__ BL,
                                         bf16_t* __restrict__ CT, float* __restrict__ NST, float* __restrict__ MST, float* __restrict__ C_p, float* __restrict__ n_p, float* __restrict__ m_p) {
    int tid_ = threadIdx.x; asm volatile("" : "+v"(tid_));
    for (int e = vcu * 512 + tid_; e < NB * MH * 16384; e += G * 512) {
        const int bh = e >> 14, idx = e & 16383, dv = idx >> 7, dk = idx & 127;
        float C = 0.f, n = 0.f, m = 0.f; const bool do_n = idx < 128, do_m = idx == 0;
        for (int c0 = 0; c0 < NCH; c0 += 8) {
            float d[8], dn[8];
#pragma unroll
            for (int j = 0; j < 8; ++j) { d[j] = DCT[(size_t)(bh * 64 + c0 + j) * 16384 + idx]; dn[j] = do_n ? DN[(size_t)(bh * 64 + c0 + j) * 128 + idx] : 0.f; }
#pragma unroll
            for (int j = 0; j < 8; ++j) { const int u = bh * 64 + c0 + j; const float al = ALAST[u], bl = BL[u];
                CT[(size_t)u * 16384 + idx] = (bf16_t)(cvt_pk_bf16(C, C) & 0xffffu);
                if (do_n) NST[(size_t)u * 128 + idx] = n;
                if (do_m) MST[u] = m;
                const float M = fmaxf(m, al), f1 = __expf(m - M), f2 = __expf(al - M);
                C = f1 * C + f2 * d[j]; n = f1 * n + f2 * dn[j]; m = bl + M; }
        }
        C_p[(size_t)bh * 16384 + dk * 128 + dv] = C;
        if (do_n) n_p[bh * 128 + idx] = n;
        if (do_m) m_p[bh] = m;
    }
}
__device__ __forceinline__ void out_pair(int pr, const bf16_t* __restrict__ MQ, const bf16_t* __restrict__ MK, const bf16_t* __restrict__ MV, const bf16_t* __restrict__ MO,
                                         const float* __restrict__ GATES, const float* __restrict__ b_i, const float* __restrict__ b_f,
                                         const bf16_t* __restrict__ CT, const float* __restrict__ NST, const float* __restrict__ MST, bf16_t* __restrict__ AB, char* lds, LAS Small* smb) {
    int tid_ = threadIdx.x; asm volatile("" : "+v"(tid_));
    const int tid = tid_, wid = tid >> 6, lane = tid & 63, r32 = lane & 31, hi = lane >> 5, hb = wid >> 2, w4 = wid & 3, ltid = tid & 255;
    const int u = 2 * pr + hb, bh = u >> 6, c = u & 63, b = bh >> 2, h = bh & 3;
    const long row0 = (long)b * S + c * 128;
    LAS Small* sm = smb + hb;
    char* Kimg = lds + hb * 65536; char* Vimg = Kimg + 32768;
    chunk_gates(sm, GATES, b_i, b_f, row0, h, ltid);
    const float mc = MST[u];
    if (ltid < 128) { const float M = fmaxf(mc, sm->cm[ltid]); sm->cm[ltid] = M; sm->ws[ltid] = __expf(mc - M); sm->bt[ltid] += M; sm->nn[ltid] = NST[(size_t)u * 128 + ltid]; }
    { const int ch = ltid & 15;
#pragma unroll
      for (int i = 0; i < 8; ++i) { const int r = (ltid >> 4) + 16 * i; const size_t g = (size_t)(row0 + r) * 512 + h * 128 + ch * 8;
          const bf16x8 kv = *reinterpret_cast<const bf16x8*>(MK + g), vv = *reinterpret_cast<const bf16x8*>(MV + g);
          *(bf16x8*)(Kimg + KSWZ(r, ch * 16)) = kv; *(bf16x8*)(Vimg + (r >> 6) * 16384 + v_st(r & 63, ch * 8)) = vv; } }
    const int t = 32 * w4 + r32;
    bf16x8 qr[8];
    { const bf16_t* qp = MQ + (size_t)(row0 + t) * 512 + h * 128 + hi * 8;
#pragma unroll
      for (int d0 = 0; d0 < 8; ++d0) qr[d0] = *reinterpret_cast<const bf16x8*>(qp + d0 * 16); }
    __syncthreads();
    const float Mt = sm->cm[t], wint = sm->ws[t], mrow = sm->bt[t];
    f32x16 o[4] = {}; float rsum = 0.f;
    const int vbV = (int)(uintptr_t)Vimg + v_rd_base(lane);
    for (int j = 0; j <= (w4 >> 1); ++j) {
        f32x16 p0, p1; att::qkt<8>(p0, p1, Kimg + j * 16384, qr, r32, hi);
#pragma unroll
        for (int r = 0; r < 16; ++r) { const int s0 = 64 * j + crow(r, hi);
            const float e0 = (s0 <= t) ? __builtin_amdgcn_exp2f((sm->at[s0] - Mt) * LOG2E) : 0.f, e1 = (s0 + 32 <= t) ? __builtin_amdgcn_exp2f((sm->at[s0 + 32] - Mt) * LOG2E) : 0.f;
            p0[r] *= e0; p1[r] *= e1; rsum += p0[r] + p1[r]; }
        bf16x8 pa0, pa1, pa2, pa3;
        ATT_PK4(p0, 0, pa0); ATT_PK4(p0, 8, pa1); ATT_PK4(p1, 0, pa2); ATT_PK4(p1, 8, pa3);
        const int vb = vbV + j * 16384;
        att::pv_one<0>(o[0], vb, pa0, pa1, pa2, pa3); att::pv_one<1>(o[1], vb, pa0, pa1, pa2, pa3); att::pv_one<2>(o[2], vb, pa0, pa1, pa2, pa3); att::pv_one<3>(o[3], vb, pa0, pa1, pa2, pa3);
    }
    float qn = 0.f;
    __syncthreads();
    { const int ch = ltid & 15; const bf16_t* ctg = CT + (size_t)u * 16384;
#pragma unroll
      for (int i = 0; i < 8; ++i) { const int r = (ltid >> 4) + 16 * i; *(bf16x8*)(Kimg + KSWZ(r, ch * 16)) = *reinterpret_cast<const bf16x8*>(ctg + (size_t)r * 128 + ch * 8); if (i == 3) asm volatile("" ::: "memory"); } }
    __syncthreads();
#pragma unroll
    for (int ks = 0; ks < 8; ++ks) {
        const u32x4 x = __builtin_bit_cast(u32x4, qr[ks]);
        const float q0 = bflo(x.x), q1 = bfhi(x.x), q2 = bflo(x.y), q3 = bfhi(x.y), q4 = bflo(x.z), q5 = bfhi(x.z), q6 = bflo(x.w), q7 = bfhi(x.w);
        const int kb = 16 * ks + 8 * hi;
        qn += q0 * sm->nn[kb] + q1 * sm->nn[kb + 1] + q2 * sm->nn[kb + 2] + q3 * sm->nn[kb + 3] + q4 * sm->nn[kb + 4] + q5 * sm->nn[kb + 5] + q6 * sm->nn[kb + 6] + q7 * sm->nn[kb + 7];
        u32x4 y; y.x = cvt_pk_bf16(q0 * wint, q1 * wint); y.y = cvt_pk_bf16(q2 * wint, q3 * wint); y.z = cvt_pk_bf16(q4 * wint, q5 * wint); y.w = cvt_pk_bf16(q6 * wint, q7 * wint);
        const bf16x8 qs = __builtin_bit_cast(bf16x8, y);
        const int cb = (ks * 16 + hi * 8) * 2;
#pragma unroll
        for (int d0 = 0; d0 < 4; ++d0) { const bf16x8 bfr = *reinterpret_cast<const bf16x8*>(Kimg + KSWZ(32 * d0 + r32, cb));
            o[d0] = __builtin_amdgcn_mfma_f32_32x32x16_bf16(qs, bfr, o[d0], 0, 0, 0); } }
    { auto rr = __builtin_amdgcn_permlane32_swap(__float_as_uint(rsum), __float_as_uint(rsum), false, false); rsum = __uint_as_float(rr[0]) + __uint_as_float(rr[1]); }
    { auto rr = __builtin_amdgcn_permlane32_swap(__float_as_uint(qn), __float_as_uint(qn), false, false); qn = __uint_as_float(rr[0]) + __uint_as_float(rr[1]); }
    const float den = fmaxf(fabsf(rsum + qn * wint), __expf(-mrow));
    LAS float* li = sm->red + w4 * 32;
    __syncthreads();
    if (hi == 0) li[r32] = 1.f / den;
    asm volatile("s_waitcnt lgkmcnt(0)" ::: "memory");
    int zo = 0; asm volatile("" : "+v"(zo));
    const bf16_t* mo = MO + (size_t)row0 * 512 + h * 128 + zo; bf16_t* ab = AB + (size_t)row0 * DM + 512 + h * 128 + zo;
#pragma unroll
    for (int r = 0; r < 16; ++r) { const int tr = 32 * w4 + crow(r, hi); const float rl = li[crow(r, hi)]; float ss = 0.f; float hv[4];
#pragma unroll
        for (int d0 = 0; d0 < 4; ++d0) { const float og = bf2f(mo[(size_t)tr * 512 + 32 * d0 + r32]); hv[d0] = o[d0][r] * rl * fast_sigmoid(og); ss += hv[d0] * hv[d0]; }
        ss += __shfl_xor(ss, 1); ss += __shfl_xor(ss, 2); ss += __shfl_xor(ss, 4); ss += __shfl_xor(ss, 8); ss += __shfl_xor(ss, 16);
        const float rs = rsqrtf(ss * (1.f / 128.f) + EPS);
#pragma unroll
        for (int d0 = 0; d0 < 4; ++d0) { const float v = hv[d0] * rs; ab[(size_t)tr * DM + 32 * d0 + r32] = (bf16_t)(cvt_pk_bf16(v, v) & 0xffffu); } }
    __syncthreads();
}
__device__ __forceinline__ void sample_step(int u, const bf16_t* __restrict__ MQ, const bf16_t* __restrict__ MK, const bf16_t* __restrict__ MV, const bf16_t* __restrict__ MO,
                                            const float* __restrict__ GATES, const float* __restrict__ b_i, const float* __restrict__ b_f,
                                            const float* __restrict__ sC, const float* __restrict__ sn, const float* __restrict__ smst,
                                            float* __restrict__ C_s, float* __restrict__ n_s, float* __restrict__ m_s, bf16_t* __restrict__ AB, LAS float* f  ) {
    int tid_ = threadIdx.x; asm volatile("" : "+v"(tid_)); const int tid = tid_, dv = tid & 127, part = tid >> 7, bs = u >> 2, h = u & 3;
    const size_t row = (size_t)MP + bs, g = row * 512 + h * 128;
    LAS float* qs = f; LAS float* ks = f + 128; LAS float* vs = f + 256; LAS float* nn = f + 384; LAS float* red = f + 512;
    if (tid < 128) { qs[tid] = bf2f(MQ[g + tid]); nn[tid] = sn[(size_t)u * 128 + tid]; } else if (tid < 256) ks[tid - 128] = bf2f(MK[g + tid - 128]); else if (tid < 384) vs[tid - 256] = bf2f(MV[g + tid - 256]);
    const float ig = GATES[row * 8 + h] + b_i[h], lf = log_sigmoid(GATES[row * 8 + 4 + h] + b_f[h]), m0 = smst[u];
    const float mnew = fmaxf(lf + m0, ig), a = __expf(lf + m0 - mnew), w = __expf(ig - mnew);
    __syncthreads();
    const float wv = w * vs[dv]; float pn = 0.f;
    const float* c0 = sC + (size_t)u * 16384 + (size_t)(part * 32) * 128 + dv; float* c1 = C_s + (size_t)u * 16384 + (size_t)(part * 32) * 128 + dv;
#pragma unroll 8
    for (int i = 0; i < 32; ++i) { const int dk = part * 32 + i; const float cn = fmaf(a, c0[(size_t)i * 128], wv * ks[dk]); c1[(size_t)i * 128] = cn; pn = fmaf(qs[dk], cn, pn); }
    red[part * 128 + dv] = pn;
    float nnew = 0.f;
    if (tid < 128) { nnew = fmaf(a, nn[tid], w * ks[tid]); n_s[(size_t)u * 128 + tid] = nnew; }
    __syncthreads();
    if (tid < 128) nn[tid] = nnew;
    if (tid == 0) m_s[u] = mnew;
    __syncthreads();
    float hv = 0.f;
    if (part == 0) { float qn = 0.f;
        for (int d = 0; d < 128; ++d) qn = fmaf(qs[d], nn[d], qn);
        const float den = fmaxf(fabsf(qn), __expf(-mnew)), num = red[dv] + red[128 + dv] + red[256 + dv] + red[384 + dv];
        hv = num / den * fast_sigmoid(bf2f(MO[g + dv])); }
    __syncthreads();
    if (part == 0) vs[dv] = hv;
    __syncthreads();
    if (part == 0) { float ss = 0.f;
        for (int d = 0; d < 128; ++d) ss = fmaf(vs[d], vs[d], ss);
        const float v = hv * rsqrtf(ss * (1.f / 128.f) + EPS);
        AB[row * DM + 512 + h * 128 + dv] = (bf16_t)(cvt_pk_bf16(v, v) & 0xffffu); }
    __syncthreads();
}
}
namespace sa {
using namespace fx;
constexpr int NSPLIT = 4, PG_PER_UNIT = NPAGE / NSPLIT, NUNIT = MS * NSPLIT;
constexpr int TPITCH = 544, TILE_BYTES = 32 * TPITCH;
constexpr int PART_STRIDE = 8 * 256 + 16;
typedef float f32x4 __attribute__((ext_vector_type(4)));
__device__ __forceinline__ void qabs_unit(int bs, const bf16_t* __restrict__ QB, const float* __restrict__ w_uk, bf16_t* __restrict__ QABS, LAS float* f) {
    int tid_ = threadIdx.x; asm volatile("" : "+v"(tid_)); const int tid = tid_;
    f[tid] = bf2f(QB[(size_t)(MP + bs) * 768 + (tid >> 6) * 96 + (tid & 63)]);
    __syncthreads();
    const int c = tid & 255, hh = tid >> 8;
#pragma unroll
    for (int k = 0; k < 4; ++k) { const int h = hh * 4 + k; const float* w = w_uk + (size_t)c * 512 + h * 64; float s = 0.f;
#pragma unroll 8
        for (int n = 0; n < 64; n += 4) { const f32x4 wv = *(const f32x4*)(w + n); s += f[h * 64 + n] * wv[0] + f[h * 64 + n + 1] * wv[1] + f[h * 64 + n + 2] * wv[2] + f[h * 64 + n + 3] * wv[3]; }
        QABS[(size_t)(bs * 8 + h) * 256 + c] = (bf16_t)(cvt_pk_bf16(s, s) & 0xffffu); }
    __syncthreads();
}
__device__ __forceinline__ bf16x8 cvt8(f32x4 a, f32x4 b) { u32x4 w; w.x = cvt_pk_bf16(a[0], a[1]); w.y = cvt_pk_bf16(a[2], a[3]); w.z = cvt_pk_bf16(b[0], b[1]); w.w = cvt_pk_bf16(b[2], b[3]); return __builtin_bit_cast(bf16x8, w); }
__device__ __forceinline__ s16x4 tr_read_dyn(int addr) { s16x4 r; asm volatile("ds_read_b64_tr_b16 %0, %1" : "=&v"(r) : "v"(addr) : "memory"); return r; }
__device__ __forceinline__ void part_unit(int un, const bf16_t* __restrict__ QB, const bf16_t* __restrict__ QABS, const float* __restrict__ cache_c, const float* __restrict__ cache_r,
                                          const int* __restrict__ pt, float* __restrict__ PART, char* lds) {
    int tid_ = threadIdx.x; asm volatile("" : "+v"(tid_)); const int tid = tid_, wid = tid >> 6, lane = tid & 63, l16 = lane & 15, g = lane >> 4;
    const int bs = un / NSPLIT, sp = un % NSPLIT;
    char* tile = lds + wid * TILE_BYTES; const int tile_a = (int)(uintptr_t)tile;
    bf16x8 qa[8], qrp;
    if (l16 < 8) {
#pragma unroll
        for (int ks = 0; ks < 8; ++ks) qa[ks] = *reinterpret_cast<const bf16x8*>(QABS + (size_t)(bs * 8 + l16) * 256 + 32 * ks + 8 * g);
        qrp = *reinterpret_cast<const bf16x8*>(QB + (size_t)(MP + bs) * 768 + l16 * 96 + 64 + 8 * g);
    } else {
#pragma unroll
        for (int ks = 0; ks < 8; ++ks) qa[ks] = (bf16x8){0, 0, 0, 0, 0, 0, 0, 0};
        qrp = (bf16x8){0, 0, 0, 0, 0, 0, 0, 0};
    }
    float m = -1e30f, l = 0.f; f32x4 o[16];
#pragma unroll
    for (int cb = 0; cb < 16; ++cb) o[cb] = (f32x4){0.f, 0.f, 0.f, 0.f};
    constexpr float C = ATT_SCALE * LOG2E;
    const int wr_off = l16 * TPITCH + 16 * g;
    const int rd_lo = tile_a + (4 * g + (l16 >> 2)) * TPITCH + (l16 & 3) * 8;
    for (int pgi = 0; pgi < 2; ++pgi) {
        const int pg = pt[bs * NPAGE + sp * PG_PER_UNIT + wid * 2 + pgi];
        const float* cpg = cache_c + (size_t)pg * PAGE * KVL; const float* rpg = cache_r + (size_t)pg * PAGE * RD;
        for (int k0 = 0; k0 < PAGE; k0 += 32) {
            f32x4 s[2];
#pragma unroll
            for (int hf = 0; hf < 2; ++hf) { const int key = k0 + 16 * hf + l16;
                const float* cp = cpg + (size_t)key * KVL + 8 * g; const float* rp = rpg + (size_t)key * RD + 8 * g;
                const f32x4 r0 = *(const f32x4*)rp, r1 = *(const f32x4*)(rp + 4);
                f32x4 acc = (f32x4){0.f, 0.f, 0.f, 0.f};
#pragma unroll
                for (int kb = 0; kb < 2; ++kb) { f32x4 x[8];
#pragma unroll
                    for (int k4 = 0; k4 < 4; ++k4) { x[2 * k4] = *(const f32x4*)(cp + 32 * (4 * kb + k4)); x[2 * k4 + 1] = *(const f32x4*)(cp + 32 * (4 * kb + k4) + 4); }
#pragma unroll
                    for (int k4 = 0; k4 < 4; ++k4) { const int ks = 4 * kb + k4; const bf16x8 af = cvt8(x[2 * k4], x[2 * k4 + 1]);
                        *(bf16x8*)(tile + hf * 16 * TPITCH + wr_off + 64 * ks) = af;
                        acc = __builtin_amdgcn_mfma_f32_16x16x32_bf16(af, qa[ks], acc, 0, 0, 0); }
                    asm volatile("" ::: "memory"); }
                acc = __builtin_amdgcn_mfma_f32_16x16x32_bf16(cvt8(r0, r1), qrp, acc, 0, 0, 0);
                s[hf] = acc * C; asm volatile("" ::: "memory"); }
            float mx = fmaxf(fmaxf(fmaxf(s[0][0], s[0][1]), fmaxf(s[0][2], s[0][3])), fmaxf(fmaxf(s[1][0], s[1][1]), fmaxf(s[1][2], s[1][3])));
            mx = fmaxf(mx, __shfl_xor(mx, 16)); mx = fmaxf(mx, __shfl_xor(mx, 32));
            const float mn = fmaxf(m, mx), alpha = __builtin_amdgcn_exp2f(m - mn); m = mn;
            f32x4 p0, p1; float ps = 0.f;
#pragma unroll
            for (int i = 0; i < 4; ++i) { p0[i] = __builtin_amdgcn_exp2f(s[0][i] - mn); p1[i] = __builtin_amdgcn_exp2f(s[1][i] - mn); ps += p0[i] + p1[i]; }
            ps += __shfl_xor(ps, 16); ps += __shfl_xor(ps, 32);
            l = l * alpha + ps;
            const bf16x8 pf = cvt8(p0, p1);
            asm volatile("s_waitcnt lgkmcnt(0)" ::: "memory");
#define SA_RD(CB, LO, HI) const s16x4 LO = att::tr_read<(CB) * 32>(rd_lo), HI = att::tr_read<(CB) * 32 + 16 * TPITCH>(rd_lo)
#define SA_MM(CB, LO, HI) do { const bf16x8 af = (bf16x8){LO[0], LO[1], LO[2], LO[3], HI[0], HI[1], HI[2], HI[3]}; \
                o[CB] = o[CB] * alpha; o[CB] = __builtin_amdgcn_mfma_f32_16x16x32_bf16(af, pf, o[CB], 0, 0, 0); } while (0)
#define SA_PV4(B) do { SA_RD(B, l0, h0); SA_RD(B + 1, l1, h1); SA_RD(B + 2, l2, h2); SA_RD(B + 3, l3, h3); \
                asm volatile("s_waitcnt lgkmcnt(0)" ::: "memory"); __builtin_amdgcn_sched_barrier(0); \
                SA_MM(B, l0, h0); SA_MM(B + 1, l1, h1); SA_MM(B + 2, l2, h2); SA_MM(B + 3, l3, h3); } while (0)
            SA_PV4(0); SA_PV4(4); SA_PV4(8); SA_PV4(12);
#undef SA_RD
#undef SA_MM
#undef SA_PV4
            asm volatile("s_waitcnt lgkmcnt(0)" ::: "memory");
        }
    }
    int zo = 0; asm volatile("" : "+v"(zo));
    float* of = (float*)(tile + zo);
    if (l16 < 8) {
#pragma unroll
        for (int cb = 0; cb < 16; ++cb)
#pragma unroll
            for (int i = 0; i < 4; ++i) of[l16 * 256 + 16 * cb + 4 * g + i] = o[cb][i];
        if (g == 0) { of[2048 + l16] = m; of[2056 + l16] = l; }
    }
    __syncthreads();
    float* part = PART + (size_t)un * PART_STRIDE + zo; const char* ldz = lds + zo;
#pragma unroll
    for (int k = 0; k < 4; ++k) { const int e = tid + 512 * k, h = e >> 8;
        float M = -1e30f;
#pragma unroll
        for (int w = 0; w < 8; ++w) M = fmaxf(M, ((const float*)(ldz + w * TILE_BYTES))[2048 + h]);
        float v = 0.f, L = 0.f;
#pragma unroll
        for (int w = 0; w < 8; ++w) { const float* ow = (const float*)(ldz + w * TILE_BYTES); const float sc = __builtin_amdgcn_exp2f(ow[2048 + h] - M); v += sc * ow[e]; L += sc * ow[2056 + h]; }
        part[e] = v;
        if ((e & 255) == 0) { part[2048 + h] = M; part[2056 + h] = L; } }
    __syncthreads();
}
__device__ __forceinline__ void combine_unit(int bs, const float* __restrict__ PART, const bf16_t* __restrict__ QB, const bf16_t* __restrict__ QABS, const float* __restrict__ ckv_s, const float* __restrict__ kr_s,
                                             const float* __restrict__ w_uv, bf16_t* __restrict__ AB, float* __restrict__ rsqa, LAS float* ol  ) {
    int tid_ = threadIdx.x; asm volatile("" : "+v"(tid_)); const int tid = tid_, h = tid >> 6, lane = tid & 63;
    constexpr float C = ATT_SCALE * LOG2E;
    const float* cn = ckv_s + (size_t)bs * KVL; const bf16_t* qa = QABS + (size_t)(bs * 8 + h) * 256;
    float s = 0.f;
#pragma unroll
    for (int i = 0; i < 4; ++i) s += bf2f(qa[lane * 4 + i]) * cn[lane * 4 + i];
    if (lane < 32) s += bf2f(QB[(size_t)(MP + bs) * 768 + h * 96 + 64 + lane]) * kr_s[(size_t)bs * RD + lane];
    s = wave_sum(s) * C;
    float M = s;
#pragma unroll
    for (int j = 0; j < NSPLIT; ++j) M = fmaxf(M, PART[(size_t)(bs * NSPLIT + j) * PART_STRIDE + 2048 + h]);
    const float en = __builtin_amdgcn_exp2f(s - M); float L = en; float ej[NSPLIT];
#pragma unroll
    for (int j = 0; j < NSPLIT; ++j) { const float* p = PART + (size_t)(bs * NSPLIT + j) * PART_STRIDE; ej[j] = __builtin_amdgcn_exp2f(p[2048 + h] - M); L += ej[j] * p[2056 + h]; }
    const float il = 1.f / L;
#pragma unroll
    for (int i = 0; i < 4; ++i) { const int c = lane * 4 + i; float v = en * cn[c];
#pragma unroll
        for (int j = 0; j < NSPLIT; ++j) v += ej[j] * PART[(size_t)(bs * NSPLIT + j) * PART_STRIDE + h * 256 + c];
        ol[h * 256 + c] = v * il; }
    __syncthreads();
    float a = 0.f;
    for (int c = 0; c < KVL; ++c) a = fmaf(ol[h * 256 + c], w_uv[(size_t)c * 512 + h * 64 + lane], a);
    const unsigned short ab = (unsigned short)(cvt_pk_bf16(a, a) & 0xffffu);
    AB[(size_t)(MP + bs) * DM + h * 64 + lane] = ab;
    const float ar = bf2f(ab); const float ss = wave_sum(ar * ar);
    if (lane == 0) unsafeAtomicAdd(rsqa + MP + bs, ss);
    __syncthreads();
}
}
namespace sk {
using namespace fx;
__device__ __forceinline__ void piece(int p, const bf16_t* __restrict__ A  , int lda, const bf16_t* __restrict__ Bt, int ldb, int K, LAS float* red, float& lo, float& hi) {
    int tid_ = threadIdx.x; asm volatile("" : "+v"(tid_));
    const int tid = tid_, wid = tid >> 6, lane = tid & 63, l16 = lane & 15, g = lane >> 4, rb = p >> 5, cb = p & 31;
    const int kw = K >> 3, k0 = wid * kw;
    const bf16_t* ap = A + (size_t)(rb * 16 + l16) * lda + k0 + 8 * g;
    const bf16_t* bp0 = Bt + (size_t)(cb * 32 + l16) * ldb + k0 + 8 * g; const bf16_t* bp1 = bp0 + (size_t)16 * ldb;
    f32x4 acc0 = {0.f, 0.f, 0.f, 0.f}, acc1 = acc0;
#pragma unroll 4
    for (int k = 0; k < kw; k += 32) { const bf16x8 a = *reinterpret_cast<const bf16x8*>(ap + k), b0 = *reinterpret_cast<const bf16x8*>(bp0 + k), b1 = *reinterpret_cast<const bf16x8*>(bp1 + k);
        acc0 = __builtin_amdgcn_mfma_f32_16x16x32_bf16(a, b0, acc0, 0, 0, 0); acc1 = __builtin_amdgcn_mfma_f32_16x16x32_bf16(a, b1, acc1, 0, 0, 0); }
#pragma unroll
    for (int i = 0; i < 4; ++i) { red[wid * 512 + (4 * g + i) * 32 + l16] = acc0[i]; red[wid * 512 + (4 * g + i) * 32 + 16 + l16] = acc1[i]; }
    __syncthreads();
    lo = (red[tid] + red[512 + tid]) + (red[1024 + tid] + red[1536 + tid]);
    hi = (red[2048 + tid] + red[2560 + tid]) + (red[3072 + tid] + red[3584 + tid]);
    __syncthreads();
}
__device__ __forceinline__ void row_atomic(float v2, float* rsq_row) {
    v2 += __shfl_xor(v2, 1); v2 += __shfl_xor(v2, 2); v2 += __shfl_xor(v2, 4); v2 += __shfl_xor(v2, 8); v2 += __shfl_xor(v2, 16);
    if ((threadIdx.x & 31) == 0) unsafeAtomicAdd(rsq_row, v2);
}
}
namespace fk {
using namespace fx;
constexpr int NWAVES = 8, NPHASE = 13;
constexpr size_t al(size_t x) { return (x + 255) / 256 * 256; }
constexpr size_t CTL_ZERO_BYTES = 1u << 20;
constexpr int CW_BAR = 4096;
constexpr size_t RSQ_OFF = 65536, RSQ_STRIDE = (size_t)MPAD * 4;
static_assert(RSQ_OFF + 8 * RSQ_STRIDE <= CTL_ZERO_BYTES, "ctl");
constexpr size_t O_W1GU = CTL_ZERO_BYTES, O_W1D = O_W1GU + al((size_t)2 * FF * DM * 2), O_WIN = O_W1D + al((size_t)DM * FF * 2), O_WUQ = O_WIN + al((size_t)2816 * DM * 2),
    O_WUKV = O_WUQ + al((size_t)768 * QL * 2), O_WOUT = O_WUKV + al((size_t)1024 * KVL * 2), O_W2GU = O_WOUT + al((size_t)DM * DM * 2), O_W2D = O_W2GU + al((size_t)2 * FF * DM * 2),
    O_WPG = O_W2D + al((size_t)DM * FF * 2), O_WPP = O_WPG + al((size_t)DM * DM * 2), O_AB0 = O_WPP + al((size_t)DM * PLE * 2), O_AB1 = O_AB0 + al((size_t)MPAD * DM * 2),
    O_ACT = O_AB1 + al((size_t)MPAD * DM * 2), O_H = O_ACT + al((size_t)MPAD * FF * 2), O_PEB = O_H + al((size_t)MPAD * DM * 4), O_PROJ = O_PEB + al((size_t)MPAD * PLE * 2),
    O_ZKV = O_PROJ + al((size_t)MPAD * DM * 2), O_ZQ = O_ZKV + al((size_t)MPAD * KVL * 2), O_MQ = O_ZQ + al((size_t)MPAD * QL * 2), O_MK = O_MQ + al((size_t)MPAD * 512 * 2),
    O_MV = O_MK + al((size_t)MPAD * 512 * 2), O_MO = O_MV + al((size_t)MPAD * 512 * 2), O_GATES = O_MO + al((size_t)MPAD * 512 * 2), O_QB = O_GATES + al((size_t)MPAD * 8 * 4),
    O_KB = O_QB + al((size_t)MPAD * 768 * 2), O_VB = O_KB + al((size_t)MPAD * 768 * 2), O_DCT = O_VB + al((size_t)MPAD * 512 * 2), O_DN = O_DCT + al((size_t)ml::NUNIT * 16384 * 4),
    O_ALAST = O_DN + al((size_t)ml::NUNIT * 128 * 4), O_BL = O_ALAST + al((size_t)ml::NUNIT * 4), O_CT = O_BL + al((size_t)ml::NUNIT * 4), O_NST = O_CT + al((size_t)ml::NUNIT * 16384 * 2),
    O_MST = O_NST + al((size_t)ml::NUNIT * 128 * 4), O_QABS = O_MST + al((size_t)ml::NUNIT * 4), O_PART = O_QABS + al((size_t)MS * 8 * 256 * 2),
    O_ROPE = O_PART + al((size_t)sa::NUNIT * sa::PART_STRIDE * 4), WS_FAST_END = O_ROPE + al((size_t)ROPE_NPOS * 32 * 4);
constexpr int RING_BYTES = 8 * sa::TILE_BYTES;
static_assert(RING_BYTES >= pg8::STAGE_BYTES && RING_BYTES >= att::LDS_BYTES, "ring");
constexpr int SMALL_OFF = RING_BYTES, MISC_OFF = SMALL_OFF + 2 * 8192, LDS_BYTES = MISC_OFF + 256;
static_assert(LDS_BYTES <= 163840, "LDS");
static_assert(O_MV - O_MK == O_MK - O_MQ && O_MO - O_MV == O_MK - O_MQ, "MQ|MK|MV|MO stride");

#define RLX_AGENT __ATOMIC_RELAXED, __HIP_MEMORY_SCOPE_AGENT
#define LDS_WAIT() asm volatile("s_waitcnt lgkmcnt(0)" ::: "memory")
#define XB_TMO      128
#define XB_XCNT(j)  (256  + 64 * (j))
#define XB_XSUB(j)  (1280 + 64 * (j))
#define XB_XGEN(j)  (2304 + 64 * (j))
#define XB_TOP      3328
#define XB_TOPGEN   3392
#define XCD_BAR_WORDS 3456
#define XB_SPIN_CAP (1u << 18)
__device__ __forceinline__ unsigned xb_ld(unsigned* p)              { return __hip_atomic_load(p, __ATOMIC_RELAXED, __HIP_MEMORY_SCOPE_AGENT); }
__device__ __forceinline__ unsigned xb_add(unsigned* p, unsigned v) { return __hip_atomic_fetch_add(p, v, __ATOMIC_RELAXED, __HIP_MEMORY_SCOPE_AGENT); }
__device__ __forceinline__ unsigned xb_xcc_id() { return (unsigned)__builtin_amdgcn_s_getreg((3 << 11) | 20) & 0xFu; }
#define XB_SPIN(cond, bar) do { unsigned _sp = 0; while (cond) { __builtin_amdgcn_s_sleep(1); \
    if ((++_sp & 255u) == 0u) { if (xb_ld(&(bar)[XB_TMO])) break; if (_sp > XB_SPIN_CAP) { atomicAdd(&(bar)[XB_TMO], 1u); break; } } } } while (0)
struct XcdBarrier { unsigned* bar; unsigned x; volatile LAS unsigned* st; };
__device__ __forceinline__ XcdBarrier xcd_barrier_post(unsigned* bar, volatile LAS unsigned* st) {
    XcdBarrier b; b.bar = bar; b.x = xb_xcc_id(); b.st = st;
    if (threadIdx.x == 0) (void)xb_add(&bar[XB_XCNT(b.x)], 1u);
    return b;
}
__device__ __forceinline__ void xcd_barrier_complete(unsigned* bar, unsigned x, unsigned& nloc, unsigned& nx) {
    const unsigned G = gridDim.x * gridDim.y * gridDim.z;
    unsigned sum, cnt, mine, sp = 0u;
    for (;;) {
        sum = 0u; cnt = 0u; mine = 0u;
#pragma unroll
        for (unsigned j = 0; j < 16; ++j) { const unsigned c = xb_ld(&bar[XB_XCNT(j)]); sum += c; cnt += (c > 0u) ? 1u : 0u; mine = (j == x) ? c : mine; }
        if (sum == G) break;
        __builtin_amdgcn_s_sleep(1);
        if ((++sp & 255u) == 0u) { if (xb_ld(&bar[XB_TMO])) break; if (sp > XB_SPIN_CAP) { atomicAdd(&bar[XB_TMO], 1u); break; } }
    }
    nloc = mine > 0u ? mine : 1u; nx = cnt > 0u ? cnt : 1u;
}
__device__ __forceinline__ void xcd_barrier(const XcdBarrier& b) {
    asm volatile("s_waitcnt vmcnt(0)" ::: "memory");
    __syncthreads();
    if (threadIdx.x == 0) {
        unsigned* bar = b.bar;
        __builtin_amdgcn_s_waitcnt(0);
        unsigned nloc = b.st[0], nx = b.st[1];
        if (nloc == 0u) { xcd_barrier_complete(bar, b.x, nloc, nx); b.st[0] = nloc; b.st[1] = nx; }
        const unsigned old = xb_add(&bar[XB_XSUB(b.x)], 1u);
        const unsigned gen = old / nloc;
        if (old + 1u == (gen + 1u) * nloc) {
            __builtin_amdgcn_fence(__ATOMIC_RELEASE, "agent");
            asm volatile("s_waitcnt vmcnt(0)" ::: "memory");
            const unsigned og = xb_add(&bar[XB_TOP], 1u);
            const unsigned tg = og / nx;
            if (og + 1u == (tg + 1u) * nx) xb_add(&bar[XB_TOPGEN], 1u);
            else XB_SPIN(xb_ld(&bar[XB_TOPGEN]) == tg, bar);
            __builtin_amdgcn_fence(__ATOMIC_ACQUIRE, "agent");
            xb_add(&bar[XB_XGEN(b.x)], 1u);
            asm volatile("s_waitcnt vmcnt(0)" ::: "memory");
        } else {
            XB_SPIN(xb_ld(&bar[XB_XGEN(b.x)]) == gen, bar);
            __builtin_amdgcn_fence(__ATOMIC_ACQUIRE, "agent");
            asm volatile("s_waitcnt vmcnt(0)" ::: "memory");
        }
    }
    __syncthreads();
}
struct Out { float *y_p, *y_s, *ckv_p, *kr_p, *C_p, *n_p, *m_p, *ckv_s, *kr_s, *C_s, *n_s, *m_s; };
__host__ __device__ __forceinline__ Out carve_out(float* o) {
    Out r; size_t off = 0;
    r.y_p = o + off; off += (size_t)MP * DM; r.y_s = o + off; off += (size_t)MS * DM;
    r.ckv_p = o + off; off += (size_t)MP * KVL; r.kr_p = o + off; off += (size_t)MP * RD;
    r.C_p = o + off; off += (size_t)NB * MH * MD * MD; r.n_p = o + off; off += (size_t)NB * MH * MD; r.m_p = o + off; off += NB * MH;
    r.ckv_s = o + off; off += (size_t)MS * KVL; r.kr_s = o + off; off += (size_t)MS * RD;
    r.C_s = o + off; off += (size_t)MS * MH * MD * MD; r.n_s = o + off; off += (size_t)MS * MH * MD; r.m_s = o + off; off += MS * MH;
    return r;
}
constexpr size_t OUT_FLOATS = (size_t)MP * DM + (size_t)MS * DM + (size_t)MP * KVL + (size_t)MP * RD + (size_t)NB * MH * MD * MD + (size_t)NB * MH * MD + NB * MH
                            + (size_t)MS * KVL + (size_t)MS * RD + (size_t)MS * MH * MD * MD + (size_t)MS * MH * MD + MS * MH;
struct Src { const float* base; int ld; int col; float scale; };
template <class CM, class GN> __device__ __forceinline__ void tr_item(CM colmap, GN gain, int K, int nblk, bf16_t* WT, LAS float* scr, int item, int lane) {
    const int kb = item / nblk, nb = item % nblk, k0 = 64 * kb, n0 = 32 * nb;
    const Src s = colmap(n0 + (lane & 31));
#pragma unroll 8
    for (int i = 0; i < 32; ++i) { const int kk = 2 * i + (lane >> 5); scr[kk * 33 + (lane & 31)] = s.base ? s.base[(size_t)(k0 + kk) * s.ld + s.col] * gain(k0 + kk) * s.scale : 0.f; }
    LDS_WAIT(); asm volatile("" ::: "memory");
    const int c = lane & 7;
#pragma unroll
    for (int j = 0; j < 4; ++j) { const int n = (lane >> 3) + 8 * j; const LAS float* p = scr + (8 * c) * 33 + n;
        u32x4 o; o.x = cvt_pk_bf16(p[0 * 33], p[1 * 33]); o.y = cvt_pk_bf16(p[2 * 33], p[3 * 33]); o.z = cvt_pk_bf16(p[4 * 33], p[5 * 33]); o.w = cvt_pk_bf16(p[6 * 33], p[7 * 33]);
        *(u32x4*)(WT + (size_t)(n0 + n) * K + k0 + 8 * c) = o; }
    LDS_WAIT(); asm volatile("" ::: "memory");
}
struct Args { const void* in[34]; float* out; unsigned char* ws; int ph_lo, ph_hi, use_bar, pad; };

__global__ void __launch_bounds__(NWAVES * 64, 2) fwd(Args args) {
    extern __shared__ __attribute__((aligned(16))) unsigned char lds[];
    LAS unsigned char* L = (LAS unsigned char*)lds;
    const int tid = threadIdx.x, lane = tid & 63, wave = __builtin_amdgcn_readfirstlane(tid >> 6);
    const int G = gridDim.x, bx = blockIdx.x, vcu = (G % 8 == 0) ? (bx % 8) * (G / 8) + bx / 8 : bx;
    unsigned char* ws = args.ws;
    unsigned* ctl = (unsigned*)ws;
    for (int u = tid; u < (LDS_BYTES - SMALL_OFF) / 4; u += NWAVES * 64) ((LAS unsigned*)(L + SMALL_OFF))[u] = 0u;
    __syncthreads();
    XcdBarrier bar; bar.bar = ctl + CW_BAR; bar.x = 0; bar.st = nullptr;
    if (args.use_bar) bar = xcd_barrier_post(ctl + CW_BAR, (volatile LAS unsigned*)(L + MISC_OFF));
    const int lo = args.ph_lo, hi = args.ph_hi;
#ifndef SUB4
#define SUB4 0xff
#endif
#ifndef SUB6
#define SUB6 0xff
#endif
#ifndef PHASE_MASK
#define PHASE_MASK 0xffff
#endif
#define IN(k) (((PHASE_MASK >> (k)) & 1) && lo <= (k) && (k) < hi)
#define SEAM(k) do { if (IN(k) && IN((k) + 1)) xcd_barrier(bar); } while (0)
#define LDF(name, idx) const float* name = (const float*)args.in[idx]
    const Out O = carve_out(args.out);
#define P_rsq0 ((float*)(ws + RSQ_OFF))
#define P_rsq1 (P_rsq0 + MPAD)
#define P_rsqkv (P_rsq1 + MPAD)
#define P_rsqq (P_rsqkv + MPAD)
#define P_rsqa (P_rsqq + MPAD)
#define P_rsq2 (P_rsqa + MPAD)
#define P_rsq3 (P_rsq2 + MPAD)
#define P_rsq4 (P_rsq3 + MPAD)
#define P_W1GU ((bf16_t*)(ws + O_W1GU))
#define P_W1D ((bf16_t*)(ws + O_W1D))
#define P_WIN ((bf16_t*)(ws + O_WIN))
#define P_WUQ ((bf16_t*)(ws + O_WUQ))
#define P_WUKV ((bf16_t*)(ws + O_WUKV))
#define P_WOUT ((bf16_t*)(ws + O_WOUT))
#define P_W2GU ((bf16_t*)(ws + O_W2GU))
#define P_W2D ((bf16_t*)(ws + O_W2D))
#define P_WPG ((bf16_t*)(ws + O_WPG))
#define P_WPP ((bf16_t*)(ws + O_WPP))
#define P_AB0 ((bf16_t*)(ws + O_AB0))
#define P_AB1 ((bf16_t*)(ws + O_AB1))
#define P_ACT ((bf16_t*)(ws + O_ACT))
#define P_H ((float*)(ws + O_H))
#define P_PEB ((bf16_t*)(ws + O_PEB))
#define P_PROJ ((bf16_t*)(ws + O_PROJ))
#define P_ZKV ((bf16_t*)(ws + O_ZKV))
#define P_ZQ ((bf16_t*)(ws + O_ZQ))
#define P_MQ ((bf16_t*)(ws + O_MQ))
#define P_MK ((bf16_t*)(ws + O_MK))
#define P_MV ((bf16_t*)(ws + O_MV))
#define P_MO ((bf16_t*)(ws + O_MO))
#define P_GATES ((float*)(ws + O_GATES))
#define P_QB ((bf16_t*)(ws + O_QB))
#define P_KB ((bf16_t*)(ws + O_KB))
#define P_VB ((bf16_t*)(ws + O_VB))
#define P_DCT ((float*)(ws + O_DCT))
#define P_DN ((float*)(ws + O_DN))
#define P_ALAST ((float*)(ws + O_ALAST))
#define P_BL ((float*)(ws + O_BL))
#define P_CT ((bf16_t*)(ws + O_CT))
#define P_NST ((float*)(ws + O_NST))
#define P_MST ((float*)(ws + O_MST))
#define P_QABS ((bf16_t*)(ws + O_QABS))
#define P_PART ((float*)(ws + O_PART))
#define P_ROPE ((float*)(ws + O_ROPE))
    LAS ml::Small* smalls = (LAS ml::Small*)(L + SMALL_OFF);
    const int gw = vcu * NWAVES + wave, NGW = G * NWAVES;

    if (IN(0)) {
        int lane_ = threadIdx.x & 63; asm volatile("" : "+v"(lane_)); const int lane = lane_;
        LDF(x_p, 0); LDF(x_s, 1); LDF(p_p, 2); LDF(p_s, 3); LDF(g_ff1, 10); LDF(w1g, 11); LDF(w1u, 12); LDF(w1d, 13); LDF(g_mix, 14); LDF(w_in, 15); LDF(g_q, 16); LDF(w_uq, 17); LDF(g_kv, 18); LDF(w_uk, 19); LDF(w_uv, 20);
        LDF(g_ao, 23); LDF(g_mo, 24); LDF(w_out, 25); LDF(g_ff2, 26); LDF(w2g, 27); LDF(w2u, 28); LDF(w2d, 29); LDF(g_ple, 30); LDF(w_pg, 31); LDF(w_pp, 32);
        LAS float* scr = (LAS float*)(L + wave * 16384);
        constexpr int I_GU = (DM / 64) * (2 * FF / 32), I_D = (FF / 64) * (DM / 32), I_IN = (DM / 64) * (2816 / 32), I_UQ = (QL / 64) * (768 / 32), I_UKV = (KVL / 64) * (1024 / 32),
                      I_OUT = (DM / 64) * (DM / 32), I_PG = I_OUT, I_PP = (PLE / 64) * (DM / 32);
        constexpr int NITEMS = 2 * I_GU + 2 * I_D + I_IN + I_UQ + I_UKV + I_OUT + I_PG + I_PP;
        auto one = [](int) { return 1.f; };
        for (int it = gw; it < NITEMS; it += NGW) {
            int r = it;
            if (r < 2 * I_GU) { const bool second = r >= I_GU; if (second) r -= I_GU; const float* wg = second ? w2g : w1g; const float* wu = second ? w2u : w1u; const float* gg = second ? g_ff2 : g_ff1;
                tr_item([=](int n) { const int pn = n >> 8, q = n & 255; return (q < 128) ? Src{wg, FF, 128 * pn + q, 1.f} : Src{wu, FF, 128 * pn + q - 128, 1.f}; }, [=](int k) { return gg[k]; }, DM, 2 * FF / 32, second ? P_W2GU : P_W1GU, scr, r, lane); continue; }
            r -= 2 * I_GU;
            if (r < 2 * I_D) { const bool second = r >= I_D; if (second) r -= I_D; const float* wd = second ? w2d : w1d;
                tr_item([=](int n) { return Src{wd, DM, n, 1.f}; }, one, FF, DM / 32, second ? P_W2D : P_W1D, scr, r, lane); continue; }
            r -= 2 * I_D;
            if (r < I_IN) { tr_item([=](int n) { if (n < 256) return Src{w_in, 2728, 384 + n, 1.f}; if (n < 640) return Src{w_in, 2728, n - 256, 1.f};
                    if (n < 672) { const int j = n - 640; return Src{w_in, 2728, 640 + (j >> 1) + 16 * (j & 1), 1.f}; }
                    if (n < 676) return Src{w_in, 2728, 2720 + (n - 672), 1.f}; if (n < 680) return Src{w_in, 2728, 2724 + (n - 676), 1.f};
                    if (n < 768) return Src{nullptr, 0, 0, 0.f};
                    if (n < 1280) return Src{w_in, 2728, 672 + (n - 768), 1.f}; if (n < 1792) return Src{w_in, 2728, 1184 + (n - 1280), 0.08838834764831845f};
                    if (n < 2304) return Src{w_in, 2728, 1696 + (n - 1792), 1.f}; return Src{w_in, 2728, 2208 + (n - 2304), 1.f}; },
                    [=](int k) { return g_mix[k]; }, DM, 2816 / 32, P_WIN, scr, r, lane); continue; }
            r -= I_IN;
            if (r < I_UQ) { tr_item([=](int n) { const int h = n / 96, d = n - h * 96; if (d < 64) return Src{w_uq, 768, n, 1.f}; const int j = d - 64; return Src{w_uq, 768, h * 96 + 64 + (j >> 1) + 16 * (j & 1), 1.f}; },
                    [=](int k) { return g_q[k]; }, QL, 768 / 32, P_WUQ, scr, r, lane); continue; }
            r -= I_UQ;
            if (r < I_UKV) { tr_item([=](int n) { return n < 512 ? Src{w_uk, 512, n, 1.f} : Src{w_uv, 512, n - 512, 1.f}; }, [=](int k) { return g_kv[k]; }, KVL, 1024 / 32, P_WUKV, scr, r, lane); continue; }
            r -= I_UKV;
            if (r < I_OUT) { tr_item([=](int n) { return Src{w_out, DM, n, 1.f}; }, [=](int k) { return k < 512 ? g_ao[k] : g_mo[k - 512]; }, DM, DM / 32, P_WOUT, scr, r, lane); continue; }
            r -= I_OUT;
            if (r < I_PG) { tr_item([=](int n) { return Src{w_pg, DM, n, 1.f}; }, [=](int k) { return g_ple[k]; }, DM, DM / 32, P_WPG, scr, r, lane); continue; }
            r -= I_PG;
            tr_item([=](int n) { return Src{w_pp, DM, n, 1.f}; }, one, PLE, DM / 32, P_WPP, scr, r, lane);
        }
        for (int e = gw * 64 + lane; e < ROPE_NPOS * 16; e += NGW * 64) { float cs, sn; rope_cs(e >> 4, e & 15, cs, sn); P_ROPE[(size_t)(e >> 4) * 32 + (e & 15)] = cs; P_ROPE[(size_t)(e >> 4) * 32 + 16 + (e & 15)] = sn; }
        for (int row = gw; row < MPAD; row += NGW) {
            GAS u32x2* o8 = (GAS u32x2*)(P_AB0 + (size_t)row * DM) + lane;
            if (row < MT) { const float* xr = row < MP ? x_p + (size_t)row * DM : x_s + (size_t)(row - MP) * DM; const float* pr = row < MP ? p_p + (size_t)row * PLE : p_s + (size_t)(row - MP) * PLE;
                float s = 0.f;
#pragma unroll
                for (int j = 0; j < 4; ++j) { const f32x4 v = *((const f32x4*)xr + lane + 64 * j); s += (v.x * v.x + v.y * v.y) + (v.z * v.z + v.w * v.w); u32x2 w; w.x = cvt_pk_bf16(v.x, v.y); w.y = cvt_pk_bf16(v.z, v.w); o8[64 * j] = w; }
                s = wave_sum(s); if (lane == 0) P_rsq0[row] = s;
                const f32x4 pv = *((const f32x4*)pr + lane); u32x2 w; w.x = cvt_pk_bf16(pv.x, pv.y); w.y = cvt_pk_bf16(pv.z, pv.w); *((GAS u32x2*)(P_PEB + (size_t)row * PLE) + lane) = w;
            } else { const u32x2 z = {0u, 0u};
#pragma unroll
                for (int j = 0; j < 4; ++j) o8[64 * j] = z;
                *((GAS u32x2*)(P_PEB + (size_t)row * PLE) + lane) = z; }
        }
    }
    SEAM(0);
    if (IN(1)) { pg8::Gemm g{P_AB0, P_W1GU, MPAD, 2 * FF, DM, DM, DM}; pg8::StaticOrder So; So.init(MPAD, 2 * FF, G, bx); pg8::EpiSwiGLU E; E.act = P_ACT; E.rsq = P_rsq0;
        pg8::gemm_phase<pg8::EpiSwiGLU, pg8::StaticOrder, true, true>(L, g, So, E); }
    SEAM(1);
    if (IN(2)) { LDF(x_p, 0); LDF(x_s, 1); pg8::Gemm g{P_ACT, P_W1D, MP, DM, FF, FF, FF}; pg8::StaticOrder So; So.init(MP, DM, G, bx); pg8::EpiResid<0> E; E.xp = x_p; E.xs = x_s; E.H = P_H; E.AB = P_AB1; E.rsq = P_rsq1; E.rsqa = nullptr;
        pg8::gemm_phase<pg8::EpiResid<0>, pg8::StaticOrder, true, true>(L, g, So, E);
        for (int p = vcu; p < 256; p += G) { float lo, hi; sk::piece(p, P_ACT + (size_t)MP * FF, FF, P_W1D, FF, FF, (LAS float*)L, lo, hi);
            const int t = threadIdx.x, bs = (p >> 5) * 16 + (t >> 5), c = (p & 31) * 32 + (t & 31); const size_t off = (size_t)(MP + bs) * DM + c;
            const float hv = x_s[(size_t)bs * DM + c] + 0.5f * (lo + hi); P_H[off] = hv; P_AB1[off] = (bf16_t)(cvt_pk_bf16(hv, hv) & 0xffffu); sk::row_atomic(hv * hv, P_rsq1 + MP + bs); } }
    SEAM(2);
    if (IN(3)) { pg8::Gemm g{P_AB1, P_WIN, MPAD, 2816, DM, DM, DM}; pg8::StaticOrder So; So.init(MPAD, 2816, G, bx);
        pg8::EpiZ E; E.rsq1 = P_rsq1; E.ROPE = P_ROPE; E.ZKV = P_ZKV; E.ZQ = P_ZQ; E.KB = P_KB; E.MQ = P_MQ; E.mstride = (O_MK - O_MQ) / 2; E.GATES = P_GATES; E.ckv_p = O.ckv_p; E.ckv_s = O.ckv_s; E.kr_p = O.kr_p; E.kr_s = O.kr_s; E.rsqkv = P_rsqkv; E.rsqq = P_rsqq;
        pg8::gemm_phase<pg8::EpiZ, pg8::StaticOrder, true, true>(L, g, So, E); }
    SEAM(3);
    if (IN(4)) {
        LDF(sC, 6); LDF(sn, 7); LDF(smst, 8); LDF(g_kv, 18); LDF(b_i, 21); LDF(b_f, 22);
        if (SUB4 & 1) { pg8::Gemm g{P_ZQ, P_WUQ, MPAD, 768, QL, QL, QL}; pg8::StaticOrder So; So.init(MPAD, 768, G, bx); pg8::EpiQ E; E.rsqq = P_rsqq; E.ROPE = P_ROPE; E.QB = P_QB;
          pg8::gemm_phase<pg8::EpiQ, pg8::StaticOrder, true, true>(L, g, So, E); }
        if (SUB4 & 2) { pg8::Gemm g{P_ZKV, P_WUKV, MP, 1024, KVL, KVL, KVL}; pg8::StaticOrder So; So.init(MP, 1024, G, bx); pg8::EpiKV E; E.rsqkv = P_rsqkv; E.KB = P_KB; E.VB = P_VB; E.ckv_p = O.ckv_p; E.ckv_s = O.ckv_s; E.g_kv = g_kv;
          pg8::gemm_phase<pg8::EpiKV, pg8::StaticOrder, true, true>(L, g, So, E); }
        if (SUB4 & 4) { pg8::Gemm g{P_PEB, P_WPP, MP, DM, PLE, PLE, PLE}; pg8::StaticOrder So; So.init(MP, DM, G, bx); pg8::EpiPlain E; E.O = P_PROJ; E.ldo = DM;
          pg8::gemm_phase<pg8::EpiPlain, pg8::StaticOrder, true, true>(L, g, So, E); }
        if (SUB4 & 8) for (int pr = vcu; pr < ml::NUNIT / 2; pr += G) ml::local_pair(pr, P_MK, P_MV, P_GATES, b_i, b_f, P_DCT, P_DN, P_ALAST, P_BL, (char*)lds, smalls);
        for (int bs = vcu; bs < MS; bs += G) { const int t = threadIdx.x; if (t < KVL) O.ckv_s[(size_t)bs * KVL + t] *= rstd_of(P_rsqkv, MP + bs, 1.f / KVL) * g_kv[t]; }
        if (SUB4 & 16) for (int u = vcu; u < MS * MH; u += G) ml::sample_step(u, P_MQ, P_MK, P_MV, P_MO, P_GATES, b_i, b_f, sC, sn, smst, O.C_s, O.n_s, O.m_s, P_AB0, (LAS float*)L);
    }
    SEAM(4);
    if (IN(5)) {
        LDF(w_uk, 19);
        ml::scan_all(vcu, G, P_DCT, P_DN, P_ALAST, P_BL, P_CT, P_NST, P_MST, O.C_p, O.n_p, O.m_p);
        for (int bs = vcu; bs < MS; bs += G) sa::qabs_unit(bs, P_QB, w_uk, P_QABS, (LAS float*)L);
    }
    SEAM(5);
    if (IN(6)) {
        LDF(cache_c, 4); LDF(cache_r, 5); const int* pt = (const int*)args.in[9]; LDF(b_i, 21); LDF(b_f, 22);
        const bool sample_first = (vcu & 1) != 0;
        if ((SUB6 & 1) && sample_first) for (int un = vcu; un < sa::NUNIT; un += G) sa::part_unit(un, P_QB, P_QABS, cache_c, cache_r, pt, P_PART, (char*)lds);
        if (SUB6 & 2) for (int p = vcu; p < 256; p += G) { const int bh = p >> 4, s = p & 15;
            att::attn_unit(bh >> 3, bh & 7, s, P_QB, P_KB, P_VB, P_AB0, P_rsqa, (char*)lds); att::attn_unit(bh >> 3, bh & 7, 31 - s, P_QB, P_KB, P_VB, P_AB0, P_rsqa, (char*)lds); }
        if (SUB6 & 4) for (int pr = vcu; pr < ml::NUNIT / 2; pr += G) ml::out_pair(pr, P_MQ, P_MK, P_MV, P_MO, P_GATES, b_i, b_f, P_CT, P_NST, P_MST, P_AB0, (char*)lds, smalls);
        if ((SUB6 & 1) && !sample_first) for (int un = vcu; un < sa::NUNIT; un += G) sa::part_unit(un, P_QB, P_QABS, cache_c, cache_r, pt, P_PART, (char*)lds);
    }
    SEAM(6);
    if (IN(7)) { LDF(w_uv, 20); for (int bs = vcu; bs < MS; bs += G) sa::combine_unit(bs, P_PART, P_QB, P_QABS, O.ckv_s, O.kr_s, w_uv, P_AB0, P_rsqa, (LAS float*)L); }
    SEAM(7);
    if (IN(8)) { pg8::Gemm g{P_AB0, P_WOUT, MP, DM, DM, DM, DM}; pg8::StaticOrder So; So.init(MP, DM, G, bx); pg8::EpiResid<1> E; E.xp = nullptr; E.xs = nullptr; E.H = P_H; E.AB = P_AB1; E.rsq = P_rsq2; E.rsqa = P_rsqa;
        pg8::gemm_phase<pg8::EpiResid<1>, pg8::StaticOrder, true, true>(L, g, So, E);
        for (int p = vcu; p < 256; p += G) { float lo, hi; sk::piece(p, P_AB0 + (size_t)MP * DM, DM, P_WOUT, DM, DM, (LAS float*)L, lo, hi);
            const int t = threadIdx.x, bs = (p >> 5) * 16 + (t >> 5), c = (p & 31) * 32 + (t & 31); const size_t off = (size_t)(MP + bs) * DM + c;
            const float hv = P_H[off] + lo * rstd_of(P_rsqa, MP + bs, 1.f / 512.f) + hi; P_H[off] = hv; P_AB1[off] = (bf16_t)(cvt_pk_bf16(hv, hv) & 0xffffu); sk::row_atomic(hv * hv, P_rsq2 + MP + bs); } }
    SEAM(8);
    if (IN(9)) { pg8::Gemm g{P_AB1, P_W2GU, MPAD, 2 * FF, DM, DM, DM}; pg8::StaticOrder So; So.init(MPAD, 2 * FF, G, bx); pg8::EpiSwiGLU E; E.act = P_ACT; E.rsq = P_rsq2;
        pg8::gemm_phase<pg8::EpiSwiGLU, pg8::StaticOrder, true, true>(L, g, So, E); }
    SEAM(9);
    if (IN(10)) { pg8::Gemm g{P_ACT, P_W2D, MP, DM, FF, FF, FF}; pg8::StaticOrder So; So.init(MP, DM, G, bx); pg8::EpiResid<2> E; E.xp = nullptr; E.xs = nullptr; E.H = P_H; E.AB = P_AB0; E.rsq = P_rsq3; E.rsqa = nullptr;
        pg8::gemm_phase<pg8::EpiResid<2>, pg8::StaticOrder, true, true>(L, g, So, E);
        for (int p = vcu; p < 256; p += G) { float lo, hi; sk::piece(p, P_ACT + (size_t)MP * FF, FF, P_W2D, FF, FF, (LAS float*)L, lo, hi);
            const int t = threadIdx.x, bs = (p >> 5) * 16 + (t >> 5), c = (p & 31) * 32 + (t & 31); const size_t off = (size_t)(MP + bs) * DM + c;
            const float hv = P_H[off] + 0.5f * (lo + hi); P_H[off] = hv; P_AB0[off] = (bf16_t)(cvt_pk_bf16(hv, hv) & 0xffffu); sk::row_atomic(hv * hv, P_rsq3 + MP + bs); } }
    SEAM(10);
    if (IN(11)) { pg8::Gemm g{P_AB0, P_WPG, MP, DM, DM, DM, DM}; pg8::StaticOrder So; So.init(MP, DM, G, bx); pg8::EpiPle E; E.rsq3 = P_rsq3; E.PROJ = P_PROJ; E.H = P_H; E.y_p = O.y_p; E.y_s = O.y_s; E.rsq4 = P_rsq4;
        pg8::gemm_phase<pg8::EpiPle, pg8::StaticOrder, true, true>(L, g, So, E);
        for (int p = vcu; p < 256; p += G) { float lo, hi, pl, ph; sk::piece(p, P_AB0 + (size_t)MP * DM, DM, P_WPG, DM, DM, (LAS float*)L, lo, hi); sk::piece(p, P_PEB + (size_t)MP * PLE, PLE, P_WPP, PLE, PLE, (LAS float*)L, pl, ph);
            const int t = threadIdx.x, bs = (p >> 5) * 16 + (t >> 5), c = (p & 31) * 32 + (t & 31);
            const float yv = P_H[(size_t)(MP + bs) * DM + c] + fast_sigmoid((lo + hi) * rstd_of(P_rsq3, MP + bs, 1.f / DM)) * (pl + ph); O.y_s[(size_t)bs * DM + c] = yv; sk::row_atomic(yv * yv, P_rsq4 + MP + bs); } }
    SEAM(11);
    if (IN(12)) {
        int lane_ = threadIdx.x & 63; asm volatile("" : "+v"(lane_)); const int lane = lane_;
        LDF(g_fin, 33);
        for (int row = gw; row < MT; row += NGW) { float* yr = row < MP ? O.y_p + (size_t)row * DM : O.y_s + (size_t)(row - MP) * DM; const float rs = rstd_of(P_rsq4, row, 1.f / DM);
#pragma unroll
            for (int j = 0; j < 4; ++j) { f32x4 v = *((f32x4*)yr + lane + 64 * j); const f32x4 gv = *((const f32x4*)g_fin + lane + 64 * j); v = v * gv * rs; *((f32x4*)yr + lane + 64 * j) = v; } }
    }
#undef IN
#undef SEAM
}
}
#ifndef DBG
#define DBG 0
#endif
#ifndef DBG_REPORT
#define DBG_REPORT -1
#endif
#if DBG
namespace dbg {
using namespace fx;
template <class TT> __device__ __forceinline__ float ldt(const TT* p);
template <> __device__ __forceinline__ float ldt<float>(const float* p) { return *p; }
template <> __device__ __forceinline__ float ldt<unsigned short>(const unsigned short* p) { return bf2f(*p); }
template <class TT> __global__ void check_k(const float* __restrict__ ref, int ldr, const TT* __restrict__ test, int ldtst, int rows, int cols, float ts, float* acc, int id) {
    float d2 = 0.f, r2 = 0.f;
    for (size_t i = (size_t)blockIdx.x * 256 + threadIdx.x; i < (size_t)rows * cols; i += (size_t)gridDim.x * 256) { const size_t r = i / cols, c = i % cols;
        const float a = ref[r * ldr + c], b = ts * ldt<TT>(test + r * ldtst + c); const float d = a - b; d2 += d * d; r2 += a * a; }
    d2 = wave_sum(d2); r2 = wave_sum(r2);
    if ((threadIdx.x & 63) == 0) { atomicAdd(acc + 2 * id, d2); atomicAdd(acc + 2 * id + 1, r2); }
}
__global__ void verdict_k(float* acc, int id, float tol, int code, unsigned* flag, float* ratios) {
    const float ratio = acc[2 * id] / acc[2 * id + 1];
    ratios[id] = ratio;
    if (!(ratio <= tol)) atomicMax(flag, (unsigned)code);
}
__global__ void poison_k(const unsigned* flag, const float* ratios, float* m_s, int report) {
    const unsigned f = *flag; float s = 1.f;
    if (f) s = 1.f + (float)f; else if (report >= 0) s = 1.f + sqrtf(ratios[report]);
    m_s[threadIdx.x] *= s;
}
}
#endif

extern "C" void kernel_launch(void* const* d_in, const int* in_sizes, int n_in, void* d_out, int out_size, void* d_ws, size_t ws_size, hipStream_t stream) {
    using namespace fk;
    static int grid = 0;
    if (grid == 0) {
        int dev = 0, cus = 0, per_cu = 0;
        if (hipGetDevice(&dev) != hipSuccess || hipDeviceGetAttribute(&cus, hipDeviceAttributeMultiprocessorCount, dev) != hipSuccess) { fprintf(stderr, "kernel_launch: device query failed\n"); grid = -1; return; }
        if (hipFuncSetAttribute((const void*)fwd, hipFuncAttributeMaxDynamicSharedMemorySize, LDS_BYTES) != hipSuccess) { fprintf(stderr, "kernel_launch: hipFuncSetAttribute failed\n"); grid = -1; return; }
        if (hipOccupancyMaxActiveBlocksPerMultiprocessor(&per_cu, (const void*)fwd, NWAVES * 64, LDS_BYTES) != hipSuccess || per_cu < 1) fprintf(stderr, "kernel_launch: occupancy query reports %d\n", per_cu);
        (void)hipGetLastError();
        if (n_in != 34 || (size_t)out_size != OUT_FLOATS || ws_size < WS_FAST_END) { fprintf(stderr, "kernel_launch: shape mismatch n_in %d out %d ws %zu\n", n_in, out_size, ws_size); grid = -1; return; }
        grid = cus;
    }
    if (grid < 0) return;
    (void)hipMemsetAsync(d_ws, 0, CTL_ZERO_BYTES, stream);
    Args a{};
    for (int i = 0; i < 34; ++i) a.in[i] = d_in[i];
    a.ws = (unsigned char*)d_ws;
#if !DBG
    a.out = (float*)d_out; a.ph_lo = 0; a.ph_hi = NPHASE; a.use_bar = 1; a.pad = 0;
    hipLaunchKernelGGL(fwd, dim3(grid), dim3(NWAVES * 64), LDS_BYTES, stream, a);
#else
    constexpr size_t FOUT_OFF = (WS_FAST_END + 4095) / 4096 * 4096, NAIVE_OFF = (FOUT_OFF + OUT_FLOATS * 4 + 4095) / 4096 * 4096;
    float* fout = (float*)((char*)d_ws + FOUT_OFF); float* nws = (float*)((char*)d_ws + NAIVE_OFF);
    float* acc = (float*)((char*)d_ws + 49152); unsigned* flag = (unsigned*)(acc + 128); float* ratios = acc + 160;
    a.out = fout; a.use_bar = 0; a.pad = 0;
    const Out FO = carve_out(fout);
    unsigned char* ws = (unsigned char*)d_ws;
    auto phases = [&](int lo, int hi) { for (int p = lo; p < hi; ++p) { a.ph_lo = p; a.ph_hi = p + 1; hipLaunchKernelGGL(fwd, dim3(grid), dim3(NWAVES * 64), LDS_BYTES, stream, a); } };
    int next_id = 0;
    auto chk_f = [&](const float* ref, int ldr, const float* t, int ldtst, int rows, int cols, float ts, int code, float tol) { const int id = next_id++;
        dbg::check_k<float><<<1024, 256, 0, stream>>>(ref, ldr, t, ldtst, rows, cols, ts, acc, id); dbg::verdict_k<<<1, 1, 0, stream>>>(acc, id, tol, code, flag, ratios); };
    auto chk_b = [&](const float* ref, int ldr, const void* t, int ldtst, int rows, int cols, float ts, int code, float tol) { const int id = next_id++;
        dbg::check_k<unsigned short><<<1024, 256, 0, stream>>>(ref, ldr, (const unsigned short*)t, ldtst, rows, cols, ts, acc, id); dbg::verdict_k<<<1, 1, 0, stream>>>(acc, id, tol, code, flag, ratios); };
    const float TOL = 1e-3f;
    auto hook = [&](int stage, const nv::Ws& w, const nv::Out& NO) {
        if (stage == 1) { phases(0, 2); chk_b(w.G, FF, ws + O_ACT, FF, MT, FF, 1.f, 30, TOL); }
        else if (stage == 2) { phases(2, 3); chk_f(w.h1, DM, (const float*)(ws + O_H), DM, MT, DM, 1.f, 29, TOL); }
        else if (stage == 3) { phases(3, 4);
            chk_b(w.z + 384, 2728, ws + O_ZKV, KVL, MT, KVL, 1.f, 28, TOL);
            chk_b(w.z, 2728, ws + O_ZQ, QL, MT, QL, 1.f, 27, TOL);
            chk_b(w.z + 672, 2728, ws + O_MQ, 512, MT, 512, 1.f, 26, TOL);
            chk_b(w.z + 1184, 2728, ws + O_MK, 512, MT, 512, 11.313708498984761f, 25, TOL);
            chk_b(w.z + 1696, 2728, ws + O_MV, 512, MT, 512, 1.f, 24, TOL);
            chk_b(w.z + 2208, 2728, ws + O_MO, 512, MT, 512, 1.f, 23, TOL);
            chk_f(w.z + 2720, 2728, (const float*)(ws + O_GATES), 8, MT, 8, 1.f, 22, TOL);
            chk_f(NO.kr_p, RD, FO.kr_p, RD, MP, RD, 1.f, 21, TOL); chk_f(NO.kr_s, RD, FO.kr_s, RD, MS, RD, 1.f, 21, TOL); }
        else if (stage == 4) { phases(4, 5);
            chk_b(w.q, 768, ws + O_QB, 768, MT, 768, 1.f, 20, TOL);
            chk_b(w.v, 512, ws + O_VB, 512, MP, 512, 1.f, 19, TOL);
            chk_f(NO.ckv_p, KVL, FO.ckv_p, KVL, MP, KVL, 1.f, 18, TOL); chk_f(NO.ckv_s, KVL, FO.ckv_s, KVL, MS, KVL, 1.f, 18, TOL);
            chk_b(w.pp, DM, ws + O_PROJ, DM, MT, DM, 1.f, 17, TOL);
            chk_f(NO.C_s, 128, FO.C_s, 128, MS * MH * MD, 128, 1.f, 16, TOL); chk_f(NO.n_s, 128, FO.n_s, 128, MS * MH, 128, 1.f, 16, TOL); chk_f(NO.m_s, 4, FO.m_s, 4, MS, 4, 1.f, 16, TOL);
            chk_b(w.G + (size_t)MP * 512, 512, (const unsigned short*)(ws + O_AB0) + (size_t)MP * DM + 512, DM, MS, 512, 1.f, 15, TOL); }
        else if (stage == 5) { phases(5, 8);
            chk_f(NO.C_p, 128, FO.C_p, 128, NB * MH * MD, 128, 1.f, 14, TOL); chk_f(NO.n_p, 128, FO.n_p, 128, NB * MH, 128, 1.f, 13, TOL); chk_f(NO.m_p, 4, FO.m_p, 4, NB, 4, 1.f, 13, TOL);
            chk_b(w.G, 512, (const unsigned short*)(ws + O_AB0) + 512, DM, MP, 512, 1.f, 12, TOL);
            chk_b(w.att, 512, ws + O_AB0, DM, MP, 512, 1.f, 11, TOL);
            chk_b(w.att + (size_t)MP * 512, 512, (const unsigned short*)(ws + O_AB0) + (size_t)MP * DM, DM, MS, 512, 1.f, 10, TOL); }
        else if (stage == 6) { phases(8, 9); chk_f(w.h2, DM, (const float*)(ws + O_H), DM, MT, DM, 1.f, 9, TOL); }
        else if (stage == 7) { phases(9, 10); chk_b(w.G, FF, ws + O_ACT, FF, MT, FF, 1.f, 8, TOL); }
        else if (stage == 8) { phases(10, 11); chk_f(w.h3, DM, (const float*)(ws + O_H), DM, MT, DM, 1.f, 7, TOL); }
        else if (stage == 9) { phases(11, 13); chk_f(NO.y_p, DM, FO.y_p, DM, MP, DM, 1.f, 6, TOL); chk_f(NO.y_s, DM, FO.y_s, DM, MS, DM, 1.f, 5, TOL); }
    };
    nv::run(d_in, (float*)d_out, nws, stream, hook);
    dbg::poison_k<<<1, MS * MH, 0, stream>>>(flag, ratios, nv::carve_out((float*)d_out).m_s, DBG_REPORT);
#endif
    const hipError_t le = hipPeekAtLastError();
    if (le != hipSuccess) fprintf(stderr, "kernel_launch: launch failed: %s\n", hipGetErrorName(le));
}
```
